# Optimizing an MI355X kernel written in HIP

```python
import jax, jax.numpy as jnp
from jax import lax
import numpy as np

D_MODEL = 1024
BATCH = 32
SEQ = 256
DEPTH = 1
DEC_BATCH = 4
DEC_SEQ = 1024
PAST_LEN = 256

GRID_W = 64
HEAD_DIM = 64
A_WIDTH = D_MODEL
A_HEADS = A_WIDTH // HEAD_DIM
DECAY_LORA = 64
ICLR_LORA = 64
CONV_W = 3
B_WIDTH = D_MODEL
B_Q_HEADS = B_WIDTH // HEAD_DIM
B_KV_HEADS = 4
B_GROUPS = B_Q_HEADS // B_KV_HEADS
KV_WIDTH = B_KV_HEADS * HEAD_DIM
WINDOW = 128
BLOCK = 128
KSPAN = BLOCK + 2 * WINDOW
ROPE_BASE = 10000.0
RMS_EPS = 1e-6
GN_EPS = 64e-5
NEG_INF = -1e30
ATTN_SCALE = HEAD_DIM ** -0.5
A_COLS = 3 * A_WIDTH + DECAY_LORA + ICLR_LORA
IN_SIZES = (A_COLS, A_WIDTH, B_WIDTH, KV_WIDTH, KV_WIDTH, B_WIDTH, D_MODEL, D_MODEL)
IN_WIDTH = A_COLS + A_WIDTH + 2 * B_WIDTH + 2 * KV_WIDTH + 2 * D_MODEL

kernel_name = "hybrid_rwkv7_swa_prefix_dit_step"

F32 = jnp.float32


def _split_points(sizes):
    pts, acc = [], 0
    for s in sizes[:-1]:
        acc += s
        pts.append(acc)
    return pts


def _rmsnorm(x, w):
    xf = x.astype(F32)
    y = xf * lax.rsqrt(jnp.mean(xf * xf, axis=-1, keepdims=True) + RMS_EPS)
    return (y * w).astype(x.dtype)


def _modulation(cond, w_ada, b_ada):
    m = jax.nn.silu(cond) @ w_ada + b_ada
    shift, scale, gate = jnp.split(m, 3, axis=-1)
    return shift[:, None], scale[:, None], gate[:, None]


def _short_conv(z, w):
    zp = jnp.pad(z, ((0, 0), (1, 1), (0, 0)))
    return w[0] * zp[:, :-2] + w[1] * z + w[2] * zp[:, 2:]


def _axial_rope(x):
    T = x.shape[-2]
    n_rows = T // GRID_W
    row = jnp.repeat(jnp.arange(n_rows), GRID_W)
    col = jnp.tile(jnp.arange(GRID_W), n_rows)
    half = HEAD_DIM // 2
    nf = half // 2
    inv = ROPE_BASE ** (-jnp.arange(nf, dtype=F32) / nf)

    def rot(xp, pos):
        ang = pos.astype(F32)[:, None] * inv[None, :]
        cos = jnp.cos(ang).astype(x.dtype)
        sin = jnp.sin(ang).astype(x.dtype)
        x1, x2 = xp[..., :nf], xp[..., nf:]
        return jnp.concatenate([x1 * cos - x2 * sin, x1 * sin + x2 * cos], axis=-1)

    return jnp.concatenate([rot(x[..., :half], row), rot(x[..., half:], col)], axis=-1)


def _wkv_scan(s0, r, w, k, v, a, b, reverse):
    def tm(t):
        return jnp.swapaxes(t.astype(F32), 0, 1)

    def step(s, inp):
        r_t, w_t, k_t, v_t, a_t, b_t = inp
        sa = jnp.einsum('bhvk,bhk->bhv', s, a_t)
        s = s * w_t[:, :, None, :] + sa[..., None] * b_t[:, :, None, :] + v_t[..., None] * k_t[:, :, None, :]
        return s, jnp.einsum('bhvk,bhk->bhv', s, r_t)

    s_fin, y = lax.scan(step, s0.astype(F32), (tm(r), tm(w), tm(k), tm(v), tm(a), tm(b)), reverse=reverse)
    return s_fin, jnp.swapaxes(y, 0, 1)


def _rwkv_branch(za, s0, p):
    B, T, _ = za.shape
    r, k, v, wd, ad = jnp.split(za, [A_WIDTH, 2 * A_WIDTH, 3 * A_WIDTH, 3 * A_WIDTH + DECAY_LORA], axis=-1)

    def hd(t):
        return t.reshape(B, T, A_HEADS, HEAD_DIM)

    kk = hd((k * p['k_k']).astype(F32))
    kk = kk * lax.rsqrt(jnp.maximum(jnp.sum(kk * kk, axis=-1, keepdims=True), 1e-12))
    wd_t = jnp.tanh(wd)

    def direction(d):
        w_log = -jax.nn.softplus(-(p['w0'][d] + wd_t @ p['w_up'][d]).astype(F32)) - 0.5
        decay = jnp.exp(-jnp.exp(w_log))
        a = jax.nn.sigmoid((p['a0'][d] + ad @ p['a_up'][d]).astype(F32))
        k_d = k * (1.0 + (a - 1.0) * p['k_a'])
        return _wkv_scan(s0[:, d], hd(r), hd(decay), hd(k_d), hd(v), -kk, kk * hd(a), reverse=(d == 1))

    s_fwd, y_fwd = direction(0)
    s_bwd, y_bwd = direction(1)
    y = y_fwd + y_bwd
    mu = jnp.mean(y, axis=-1, keepdims=True)
    var = jnp.mean(jnp.square(y - mu), axis=-1, keepdims=True)
    y = ((y - mu) * lax.rsqrt(var + GN_EPS)).reshape(B, T, A_WIDTH) * p['ln_x_w'] + p['ln_x_b']
    bonus = jnp.sum(hd(r) * hd(k) * p['r_k'], axis=-1, keepdims=True) * hd(v)
    y = y + bonus.reshape(B, T, A_WIDTH)
    states = jnp.stack([s_fwd, s_bwd], axis=1)
    return y.astype(za.dtype), states.astype(za.dtype)


def _heads_q(q):
    B, T, _ = q.shape
    return q.reshape(B, T, B_KV_HEADS, B_GROUPS, HEAD_DIM).transpose(0, 2, 3, 1, 4)


def _heads_kv(t):
    B, T, _ = t.shape
    return t.reshape(B, T, B_KV_HEADS, HEAD_DIM).transpose(0, 2, 1, 3)


def _merge_heads(o):
    B, _, _, T, _ = o.shape
    return o.transpose(0, 3, 1, 2, 4).reshape(B, T, B_WIDTH)


def _sink_softmax(s, sink):
    col = jnp.broadcast_to(sink.astype(F32)[None, :, :, None, None], s.shape[:-1] + (1,))
    return jax.nn.softmax(jnp.concatenate([s, col], axis=-1), axis=-1)[..., :-1]


def _context_attention(q, k, v, sink):
    B, Hk, G, T, Dh = q.shape
    nb = T // BLOCK
    qb = jnp.moveaxis(q.reshape(B, Hk, G, nb, BLOCK, Dh), 3, 0)

    def one(qi):
        s = jnp.einsum('bhgqd,bhkd->bhgqk', qi, k, preferred_element_type=F32) * ATTN_SCALE
        pr = _sink_softmax(s, sink).astype(v.dtype)
        return jnp.einsum('bhgqk,bhkd->bhgqd', pr, v)

    o = lax.map(one, qb)
    return jnp.moveaxis(o, 0, 3).reshape(B, Hk, G, T, Dh)


def _latent_attention(q, k, v, k_ctx, v_ctx, sink):
    B, Hk, G, T, Dh = q.shape
    nb = T // BLOCK
    kp = jnp.pad(k, ((0, 0), (0, 0), (WINDOW, WINDOW), (0, 0)))
    vp = jnp.pad(v, ((0, 0), (0, 0), (WINDOW, WINDOW), (0, 0)))
    qrel = jnp.arange(BLOCK)
    krel = jnp.arange(KSPAN) - WINDOW
    band = jnp.abs(qrel[:, None] - krel[None, :]) <= WINDOW

    def one(i):
        start = i * BLOCK
        qi = lax.dynamic_slice_in_dim(q, start, BLOCK, axis=3)
        ki = lax.dynamic_slice_in_dim(kp, start, KSPAN, axis=2)
        vi = lax.dynamic_slice_in_dim(vp, start, KSPAN, axis=2)
        kabs = start + krel
        mask = band & ((kabs >= 0) & (kabs < T))[None, :]
        s_loc = jnp.einsum('bhgqd,bhkd->bhgqk', qi, ki, preferred_element_type=F32) * ATTN_SCALE
        s_loc = jnp.where(mask, s_loc, NEG_INF)
        s_ctx = jnp.einsum('bhgqd,bhkd->bhgqk', qi, k_ctx, preferred_element_type=F32) * ATTN_SCALE
        pr = _sink_softmax(jnp.concatenate([s_loc, s_ctx], axis=-1), sink).astype(v.dtype)
        return (jnp.einsum('bhgqk,bhkd->bhgqd', pr[..., :KSPAN], vi)
                + jnp.einsum('bhgqk,bhkd->bhgqd', pr[..., KSPAN:], v_ctx))

    o = lax.map(one, jnp.arange(nb))
    return jnp.moveaxis(o, 0, 3).reshape(B, Hk, G, T, Dh)


def _mixer_inputs(x, cond, p):
    shift, scale, gate = _modulation(cond, p['w_ada'], p['b_ada'])
    h = _rmsnorm(x, p['norm_w']) * (1.0 + scale) + shift
    z = h @ p['w_in']
    za, ga, q, kb, vb, gb, ma, mb = jnp.split(z, _split_points(IN_SIZES), axis=-1)
    za = _short_conv(za, p['conv_a'])
    return gate, za, ga, q, kb, vb, gb, ma, mb


def _merge(x, gate, y_a, g_a, y_b, g_b, m_a, m_b, p):
    branch_a = (y_a * jax.nn.silu(g_a)) @ p['w_oA']
    branch_b = (y_b * jax.nn.silu(g_b)) @ p['w_oB']
    merged = jax.nn.sigmoid(m_a) * branch_a + jax.nn.sigmoid(m_b) * branch_b
    return x + gate * (merged @ p['w_out'])


def _context_layer(x, c_ctx, p):
    B = x.shape[0]
    gate, za, ga, q, kb, vb, gb, ma, mb = _mixer_inputs(x, c_ctx[None], p)
    s0 = jnp.zeros((B, 2, A_HEADS, HEAD_DIM, HEAD_DIM), za.dtype)
    y_a, s_ctx = _rwkv_branch(za, s0, p)
    k_c, v_c = _heads_kv(kb), _heads_kv(vb)
    y_b = _merge_heads(_context_attention(_heads_q(q), k_c, v_c, p['sink']))
    return _merge(x, gate, y_a, ga, y_b, gb, ma, mb, p), k_c, v_c, s_ctx


def _latent_layer(x, c, k_ctx, v_ctx, s_ctx, p):
    gate, za, ga, q, kb, vb, gb, ma, mb = _mixer_inputs(x, c, p)
    y_a, _ = _rwkv_branch(za, s_ctx, p)
    qh = _axial_rope(_heads_q(q))
    kh = _axial_rope(_heads_kv(kb))
    y_b = _merge_heads(_latent_attention(qh, kh, _heads_kv(vb), k_ctx, v_ctx, p['sink']))
    return _merge(x, gate, y_a, ga, y_b, gb, ma, mb, p)


def setup_inputs(seed: int = 0) -> dict:
    key = jax.random.key(seed)
    ks = jax.random.split(key, 32)

    def nrm(i, shape, s):
        return s * jax.random.normal(ks[i], shape, F32)

    L = DEPTH
    return {
        "x_prompt": nrm(0, (BATCH, SEQ, D_MODEL), 1.0),
        "x_sample": nrm(1, (DEC_BATCH, DEC_SEQ, D_MODEL), 1.0),
        "cache_k": nrm(2, (DEC_BATCH, L, B_KV_HEADS, PAST_LEN, HEAD_DIM), 1.0),
        "cache_v": nrm(3, (DEC_BATCH, L, B_KV_HEADS, PAST_LEN, HEAD_DIM), 1.0),
        "state_rwkv": nrm(4, (DEC_BATCH, L, 2, A_HEADS, HEAD_DIM, HEAD_DIM), 0.5),
        "c": nrm(5, (DEC_BATCH, D_MODEL), 1.0),
        "c_ctx": nrm(6, (D_MODEL,), 1.0),
        "norm_w": 1.0 + nrm(7, (L, D_MODEL), 0.02),
        "w_ada": nrm(8, (L, D_MODEL, 3 * D_MODEL), 0.5 * D_MODEL ** -0.5),
        "b_ada": nrm(9, (L, 3 * D_MODEL), 0.01),
        "w_in": nrm(10, (L, D_MODEL, IN_WIDTH), D_MODEL ** -0.5),
        "conv_a": jnp.array([0.0, 1.0, 0.0], F32)[None, :, None] + nrm(11, (L, CONV_W, A_COLS), 0.1),
        "w0": jax.random.uniform(ks[12], (L, 2, A_WIDTH), F32, -4.0, 1.0),
        "w_up": nrm(13, (L, 2, DECAY_LORA, A_WIDTH), 0.1),
        "a0": nrm(14, (L, 2, A_WIDTH), 0.5),
        "a_up": nrm(15, (L, 2, ICLR_LORA, A_WIDTH), 0.1),
        "k_k": 0.85 + nrm(16, (L, A_WIDTH), 0.05),
        "k_a": 1.0 + nrm(17, (L, A_WIDTH), 0.05),
        "r_k": nrm(18, (L, A_HEADS, HEAD_DIM), 0.1),
        "ln_x_w": 1.0 + nrm(19, (L, A_WIDTH), 0.02),
        "ln_x_b": nrm(20, (L, A_WIDTH), 0.01),
        "w_oA": nrm(21, (L, A_WIDTH, D_MODEL), A_WIDTH ** -0.5),
        "sink": nrm(22, (L, B_KV_HEADS, B_GROUPS), 0.5),
        "w_oB": nrm(23, (L, B_WIDTH, D_MODEL), B_WIDTH ** -0.5),
        "w_out": nrm(24, (L, D_MODEL, D_MODEL), D_MODEL ** -0.5),
        "final_norm_w": 1.0 + nrm(25, (D_MODEL,), 0.02),
    }


def reference(x_prompt, x_sample, cache_k, cache_v, state_rwkv, c, c_ctx, norm_w, w_ada, b_ada,
              w_in, conv_a, w0, w_up, a0, a_up, k_k, k_a, r_k, ln_x_w, ln_x_b, w_oA, sink, w_oB,
              w_out, final_norm_w):
    xp, xs = x_prompt, x_sample
    new_k_list, new_v_list, new_s_list = [], [], []
    for l in range(DEPTH):
        p = {
            'norm_w': norm_w[l], 'w_ada': w_ada[l], 'b_ada': b_ada[l], 'w_in': w_in[l],
            'conv_a': conv_a[l], 'w0': w0[l], 'w_up': w_up[l], 'a0': a0[l], 'a_up': a_up[l],
            'k_k': k_k[l], 'k_a': k_a[l], 'r_k': r_k[l], 'ln_x_w': ln_x_w[l], 'ln_x_b': ln_x_b[l],
            'w_oA': w_oA[l], 'sink': sink[l], 'w_oB': w_oB[l], 'w_out': w_out[l],
        }
        xp, k_c, v_c, s_c = _context_layer(xp, c_ctx, p)
        new_k_list.append(k_c)
        new_v_list.append(v_c)
        new_s_list.append(s_c)
        xs = _latent_layer(xs, c, cache_k[:, l], cache_v[:, l], state_rwkv[:, l], p)
    y_prompt = _rmsnorm(xp, final_norm_w)
    y_sample = _rmsnorm(xs, final_norm_w)
    new_k = jnp.stack(new_k_list, axis=1)
    new_v = jnp.stack(new_v_list, axis=1)
    new_state_rwkv = jnp.stack(new_s_list, axis=1)
    return (y_prompt, y_sample, new_k, new_v, new_state_rwkv)
```

```cpp
#include <hip/hip_runtime.h>
#include <hip/hip_bf16.h>
#include <hip/hip_cooperative_groups.h>
#include <cstdio>
namespace cg = cooperative_groups;

typedef unsigned short u16;
using bf16 = __hip_bfloat16;
using bf16x8 = __attribute__((ext_vector_type(8))) short;
using bf16x4 = __attribute__((ext_vector_type(4))) short;
using f32x4 = __attribute__((ext_vector_type(4))) float;
using f32x2 = __attribute__((ext_vector_type(2))) float;

constexpr int DM = 1024;
constexpr int NTOK = 12288;
constexpr int NCTX = 8192;
constexpr int INW = 8832;
constexpr int INWP = 8960;
constexpr int ZAW = 3200;
constexpr int NTHR = 512;

constexpr size_t OFF_MOD = 0;
constexpr size_t OFF_ROPE = 65536;
constexpr size_t OFF_QCTR = 81920;
constexpr size_t OFF_BAR = 98304;
constexpr size_t OFF_MCNT = 82048;
constexpr size_t OFF_PCNT = 114688;
constexpr size_t OFF_RSUM = 131072;
constexpr size_t OFF_WIN = 196608;
constexpr size_t OFF_WO = OFF_WIN + (size_t)INWP * 1024 * 2;
constexpr size_t OFF_WOUT = OFF_WO + (size_t)1024 * 2048 * 2;
constexpr size_t SZ_ACT = (size_t)NTOK * 1024 * 2;
constexpr size_t OFF_H = OFF_WOUT + (size_t)1024 * 1024 * 2;
constexpr size_t OFF_KC = OFF_H + SZ_ACT;
constexpr size_t OFF_VC = OFF_KC + SZ_ACT;
constexpr size_t OFF_ZA = OFF_VC + SZ_ACT;
constexpr size_t OFF_AQ = OFF_ZA + (size_t)NTOK * ZAW * 2;
constexpr size_t OFF_GB = OFF_AQ + 2 * SZ_ACT;
constexpr size_t OFF_KL = OFF_GB + SZ_ACT;
constexpr size_t OFF_VL = OFF_KL + (size_t)4096 * 256 * 2;
constexpr size_t OFF_WA = OFF_WIN;
constexpr size_t OFF_RN = OFF_WA + (size_t)NTOK * 128 * 2;
constexpr size_t OFF_BD = OFF_RN + (size_t)NTOK * 16 * 4;
constexpr size_t OFF_KBC = OFF_BD + (size_t)NTOK * 16 * 4;
constexpr size_t OFF_VTC = OFF_KBC + (size_t)128 * 256 * 64 * 2;
constexpr size_t OFF_KBL = OFF_VTC + (size_t)128 * 256 * 64 * 2;
constexpr size_t OFF_VTL = OFF_KBL + (size_t)16 * 1024 * 64 * 2;
constexpr size_t OFF_KBK = OFF_VTL + (size_t)16 * 1024 * 64 * 2;
constexpr size_t OFF_VTK = OFF_KBK + (size_t)16 * 256 * 64 * 2;
static_assert(OFF_VTK + (size_t)16 * 256 * 64 * 2 <= OFF_WO, "WIN region overflow");
constexpr size_t WS_NEED = OFF_VL + (size_t)4096 * 256 * 2;

constexpr size_t OUT_NEWK = (size_t)NTOK * 1024;
constexpr size_t OUT_NEWV = OUT_NEWK + (size_t)32 * 4 * 256 * 64;
constexpr size_t OUT_STATE = OUT_NEWV + (size_t)32 * 4 * 256 * 64;

struct Params {
  const float *x_prompt, *x_sample, *cache_k, *cache_v, *state, *c, *c_ctx, *norm_w, *w_ada, *b_ada, *w_in, *conv_a,
      *w0, *w_up, *a0, *a_up, *k_k, *k_a, *r_k, *ln_w, *ln_b, *w_oA, *sink, *w_oB, *w_out, *fnw;
  float* out;
  char* ws;
};

extern __shared__ __attribute__((aligned(16))) char smem_raw[];

__device__ __forceinline__ u16 f2bf(float f) {
  unsigned u = __float_as_uint(f);
  u += 0x7fffu + ((u >> 16) & 1u);
  return (u16)(u >> 16);
}
__device__ __forceinline__ float bf2f(u16 h) { return __uint_as_float(((unsigned)h) << 16); }
__device__ __forceinline__ float sigmoidf_(float x) { return __builtin_amdgcn_rcpf(1.f + __expf(-x)); }
__device__ __forceinline__ float siluf_(float x) { return x * __builtin_amdgcn_rcpf(1.f + __expf(-x)); }

__device__ __forceinline__ unsigned xb_ld(unsigned* p)              { return __hip_atomic_load(p, __ATOMIC_RELAXED, __HIP_MEMORY_SCOPE_AGENT); }
__device__ __forceinline__ unsigned xb_add(unsigned* p, unsigned v) { return __hip_atomic_fetch_add(p, v, __ATOMIC_RELAXED, __HIP_MEMORY_SCOPE_AGENT); }

typedef unsigned u32x4 __attribute__((ext_vector_type(4)));
typedef __bf16 bf16v2_t __attribute__((ext_vector_type(2)));
__device__ __forceinline__ unsigned cvt_pk_bf16(float lo, float hi) {
  f32x2 f = {lo, hi};
  bf16v2_t b = __builtin_convertvector(f, bf16v2_t);
  return __builtin_bit_cast(unsigned, b);
}

template <int CTRL>
__device__ __forceinline__ float dppf(float v) {
  return __builtin_bit_cast(float, __builtin_amdgcn_update_dpp(0, __builtin_bit_cast(int, v), CTRL, 0xf, 0xf, true));
}
__device__ __forceinline__ float red8(float v) {
  v += dppf<0xB1>(v);
  v += dppf<0x4E>(v);
  v += dppf<0x141>(v);
  return v;
}
__device__ __forceinline__ float red16(float v) {
  v = red8(v);
  v += dppf<0x140>(v);
  return v;
}
__device__ __forceinline__ float wave_sum(float v) {
  for (int o = 32; o > 0; o >>= 1) v += __shfl_xor(v, o);
  return v;
}

__device__ __forceinline__ void transpose_tile(const float* src, int lds, u16* dst, int ldd, int k0, int n0, bool zero) {
  const int tid = threadIdx.x;
  float* sm = (float*)smem_raw;
  {
    int r = tid >> 4, c4 = (tid & 15) * 4;
#pragma unroll
    for (int pass = 0; pass < 2; ++pass) {
      int rr = r + pass * 32;
      float4 v = make_float4(0, 0, 0, 0);
      if (!zero) v = *(const float4*)(src + (size_t)(k0 + rr) * lds + n0 + c4);
      sm[rr * 65 + c4 + 0] = v.x; sm[rr * 65 + c4 + 1] = v.y; sm[rr * 65 + c4 + 2] = v.z; sm[rr * 65 + c4 + 3] = v.w;
    }
  }
  __syncthreads();
  {
    int n = tid >> 3, k8 = (tid & 7) * 8;
    bf16x8 o;
#pragma unroll
    for (int e = 0; e < 8; ++e) o[e] = (short)f2bf(sm[(k8 + e) * 65 + n]);
    *(bf16x8*)(dst + (size_t)(n0 + n) * ldd + k0 + k8) = o;
  }
  __syncthreads();
}

__device__ __forceinline__ void phase0(const Params& p) {
  const int tid = threadIdx.x;
  float* mod = (float*)(p.ws + OFF_MOD);
  if (blockIdx.x == 1) {
    float* rt = (float*)(p.ws + OFF_ROPE);
    for (int idx = tid; idx < 1024; idx += NTHR) {
      int pos = idx >> 4, i = idx & 15;
      float inv = exp2f(-(float)i * (13.287712379549449f / 16.f));
      float ang = (float)pos * inv;
      rt[idx] = __cosf(ang);
      rt[1024 + idx] = __sinf(ang);
    }
  }
  float* sm = (float*)smem_raw;
  const int NMOD = 192, NTR_IN = 16 * 70, NTR = NTR_IN + 3 * 256;
  for (int item = blockIdx.x; item < NMOD + NTR; item += gridDim.x) {
    if (item < NMOD) {
      int col0 = item * 16, kg = tid >> 4, j = tid & 15;
      float* sc = sm + 4096;
#pragma unroll
      for (int q = 0; q < 10; ++q) {
        const int e = tid + q * NTHR, c = e >> 10, kx = e & 1023;
        const float cv = (c < 4) ? p.c[c * 1024 + kx] : p.c_ctx[kx];
        sc[e] = siluf_(cv);
      }
      float wv[32];
#pragma unroll
      for (int q = 0; q < 32; ++q) wv[q] = p.w_ada[(size_t)(kg * 32 + q) * 3072 + col0 + j];
      __syncthreads();
      float acc[5] = {0, 0, 0, 0, 0};
#pragma unroll
      for (int q = 0; q < 32; ++q) {
#pragma unroll
        for (int c = 0; c < 5; ++c) acc[c] += sc[c * 1024 + kg * 32 + q] * wv[q];
      }
#pragma unroll
      for (int c = 0; c < 5; ++c) sm[(kg * 5 + c) * 16 + j] = acc[c];
      __syncthreads();
      if (tid < 80) {
        int c = tid >> 4;
        float s = 0;
        for (int g = 0; g < 32; ++g) s += sm[(g * 5 + c) * 16 + j];
        mod[c * 3072 + col0 + j] = s + p.b_ada[col0 + j];
      }
      asm volatile("s_waitcnt vmcnt(0)" ::: "memory");
      __syncthreads();
      if (tid == 0) {
        __builtin_amdgcn_fence(__ATOMIC_RELEASE, "agent");
        asm volatile("s_waitcnt vmcnt(0)" ::: "memory");
        xb_add((unsigned*)(p.ws + OFF_MCNT), 1u);
      }
    } else {
      int t = item - NMOD;
      if (t < NTR_IN) {
        const int nt2 = t % 70, kt = t / 70;
        const int k0 = kt * 64, n0 = nt2 * 128;
        const int r = tid >> 4, c4 = (tid & 15) * 4;
        float4 v[2][2];
#pragma unroll
        for (int sub = 0; sub < 2; ++sub)
#pragma unroll
          for (int pass = 0; pass < 2; ++pass) {
            const int nn = n0 + sub * 64;
            v[sub][pass] = (nn < INW) ? *(const float4*)(p.w_in + (size_t)(k0 + r + pass * 32) * INW + nn + c4) : make_float4(0, 0, 0, 0);
          }
#pragma unroll
        for (int sub = 0; sub < 2; ++sub)
#pragma unroll
          for (int pass = 0; pass < 2; ++pass) {
            float* b_ = sm + sub * (64 * 65) + (r + pass * 32) * 65 + c4;
            b_[0] = v[sub][pass].x; b_[1] = v[sub][pass].y; b_[2] = v[sub][pass].z; b_[3] = v[sub][pass].w;
          }
        __syncthreads();
        {
          const int n = tid >> 3, k8 = (tid & 7) * 8;
          u16* dstp = (u16*)(p.ws + OFF_WIN);
#pragma unroll
          for (int sub = 0; sub < 2; ++sub) {
            const float* b_ = sm + sub * (64 * 65);
            u32x4 o;
            o.x = cvt_pk_bf16(b_[(k8 + 0) * 65 + n], b_[(k8 + 1) * 65 + n]); o.y = cvt_pk_bf16(b_[(k8 + 2) * 65 + n], b_[(k8 + 3) * 65 + n]);
            o.z = cvt_pk_bf16(b_[(k8 + 4) * 65 + n], b_[(k8 + 5) * 65 + n]); o.w = cvt_pk_bf16(b_[(k8 + 6) * 65 + n], b_[(k8 + 7) * 65 + n]);
            *(u32x4*)(dstp + (size_t)(n0 + sub * 64 + n) * 1024 + k0 + k8) = o;
          }
        }
        __syncthreads();
      } else {
        int u = t - NTR_IN, w = u >> 8, r = u & 255;
        int nt = r & 15, kt = r >> 4;
        if (w == 0) transpose_tile(p.w_oA, 1024, (u16*)(p.ws + OFF_WO), 2048, kt * 64, nt * 64, false);
        else if (w == 1) transpose_tile(p.w_oB, 1024, (u16*)(p.ws + OFF_WO) + 1024, 2048, kt * 64, nt * 64, false);
        else transpose_tile(p.w_out, 1024, (u16*)(p.ws + OFF_WOUT), 1024, kt * 64, nt * 64, false);
      }
    }
  }
}

__device__ __forceinline__ void phase1(const Params& p) {
  const int lane = threadIdx.x & 63, wv = threadIdx.x >> 6;
  const float* mod = (const float*)(p.ws + OFF_MOD);
  u16* H = (u16*)(p.ws + OFF_H);
  for (int tok = blockIdx.x * 8 + wv; tok < NTOK; tok += gridDim.x * 8) {
    const float* xr = (tok < NCTX) ? p.x_prompt + (size_t)tok * 1024 : p.x_sample + (size_t)(tok - NCTX) * 1024;
    int ci = (tok < NCTX) ? 4 : ((tok - NCTX) >> 10);
    float4 v[4];
    float ss = 0;
#pragma unroll
    for (int i = 0; i < 4; ++i) {
      v[i] = *(const float4*)(xr + i * 256 + lane * 4);
      ss += v[i].x * v[i].x + v[i].y * v[i].y + v[i].z * v[i].z + v[i].w * v[i].w;
    }
    ss = wave_sum(ss);
    float rstd = rsqrtf(ss * (1.f / 1024.f) + 1e-6f);
#pragma unroll
    for (int i = 0; i < 4; ++i) {
      int e = i * 256 + lane * 4;
      float4 nw = *(const float4*)(p.norm_w + e);
      float4 sh = *(const float4*)(mod + ci * 3072 + e);
      float4 sc = *(const float4*)(mod + ci * 3072 + 1024 + e);
      u16 o0 = f2bf(v[i].x * rstd * nw.x * (1.f + sc.x) + sh.x);
      u16 o1 = f2bf(v[i].y * rstd * nw.y * (1.f + sc.y) + sh.y);
      u16 o2 = f2bf(v[i].z * rstd * nw.z * (1.f + sc.z) + sh.z);
      u16 o3 = f2bf(v[i].w * rstd * nw.w * (1.f + sc.w) + sh.w);
      uint2 o;
      o.x = (unsigned)o0 | ((unsigned)o1 << 16);
      o.y = (unsigned)o2 | ((unsigned)o3 << 16);
      *(uint2*)(H + (size_t)tok * 1024 + e) = o;
    }
  }
}


#define LAS __attribute__((address_space(3)))
constexpr int BM = 256, BK = 64, HALF = 128, HTB = HALF * BK * 2, NXCD = 8, WGM = 8;
__device__ __forceinline__ int lds_byte(int r, int c) { const int st = (r >> 4) * 2 + (c >> 5), rr = r & 15, cc = c & 31, ob = rr * 64 + cc * 2; return st * 1024 + (ob ^ (((ob >> 9) & 1) << 5)); }
__device__ __forceinline__ void stage_rc(int b, int& R, int& C) { const int st = b / 1024, sb = b % 1024, swz = sb ^ (((sb >> 9) & 1) << 5); R = (st >> 1) * 16 + swz / 64; C = (st & 1) * 32 + (swz % 64) / 2; }
__device__ __forceinline__ int perm32(int rho) { const int n = rho >> 4, i = rho & 15; return 8 * (i >> 2) + 4 * n + (i & 3); }
struct Unit { int pm, pn; };
struct Gemm { const u16* A; const u16* Bt; int lda, ldb, K, M, N; };
struct StaticOrder {
  int nM, nN, nwg, G, c;
  __device__ void init(int M, int N, int G_, int c_, int rows_per_unit = BM) { nM = M / rows_per_unit; nN = N / BM; nwg = nM * nN; G = G_; c = c_; }
  __device__ bool next(int i, Unit& u) const {
    const long L = (long)i * G + c; if (L >= nwg) return false;
    int wgid = (int)L; { const int q = nwg / NXCD, r = nwg % NXCD, xcd = wgid % NXCD, off = wgid / NXCD; wgid = (xcd < r ? xcd * (q + 1) : r * (q + 1) + (xcd - r) * q) + off; }
    const int nig = WGM * nN, gid = wgid / nig, fm = gid * WGM, gsz = (nM - fm) < WGM ? (nM - fm) : WGM;
    u.pm = fm + ((wgid % nig) % gsz); u.pn = (wgid % nig) / gsz; return true;
  }
};
__device__ __forceinline__ float bflo(unsigned u) { return __uint_as_float(u << 16); }
__device__ __forceinline__ float bfhi(unsigned u) { return __uint_as_float(u & 0xffff0000u); }

struct EpiIn {
  static constexpr bool PERM = true, MID = false, AFTER_DRAIN = false;
  static constexpr int MF = 4;
  static constexpr int MIDT = 0;
  char* ws; float* out;
  __device__ __forceinline__ void mid(f32x4 (&acc)[2][2][4][2], const Unit& u, int wr, int wc, int fr, int fq) const {}
  __device__ __forceinline__ void operator()(const f32x4 (&acc)[2][2][4][2], const Unit& u, int wr, int wc, int fr, int fq) const {
    const int row0 = u.pm * BM + wr * 64 + fr;
#pragma unroll
    for (int bj = 0; bj < 2; ++bj) {
      const int cb = u.pn * BM + bj * HALF;
      const int col0 = cb + wc * 32 + 8 * fq;
      if (cb >= INW) continue;
#pragma unroll
      for (int ai = 0; ai < 2; ++ai)
#pragma unroll
        for (int m = 0; m < 4; ++m) {
          const int row = row0 + ai * HALF + m * 16;
          f32x4 v0 = acc[ai][bj][m][0], v1 = acc[ai][bj][m][1];
          if (cb >= 5248 && cb < 5760 && row < NCTX) {
            const bool isv = cb >= 5504;
            const int c = col0 - (isv ? 5504 : 5248);
            const int b = row >> 8, t = row & 255, hk = c >> 6, d = c & 63;
            float* o = out + (isv ? OUT_NEWV : OUT_NEWK) + ((size_t)(b * 4 + hk) * 256 + t) * 64 + d;
            *(f32x4*)o = v0;
            *(f32x4*)(o + 4) = v1;
            continue;
          }
          u16* dst;
          if (cb < 3200) dst = (u16*)(ws + OFF_ZA) + (size_t)row * ZAW + col0;
          else if (cb < 4224) {
            dst = (u16*)(ws + OFF_AQ) + (size_t)row * 2048 + (col0 - 3200);
#pragma unroll
            for (int j = 0; j < 4; ++j) { v0[j] = siluf_(v0[j]); v1[j] = siluf_(v1[j]); }
          } else if (cb < 5248) {
            dst = (u16*)(ws + OFF_AQ) + (size_t)row * 2048 + 1024 + (col0 - 4224);
            v0 *= 0.125f; v1 *= 0.125f;
          } else if (cb < 5504) dst = (u16*)(ws + OFF_KL) + (size_t)(row - NCTX) * 256 + (col0 - 5248);
          else if (cb < 5760) dst = (u16*)(ws + OFF_VL) + (size_t)(row - NCTX) * 256 + (col0 - 5504);
          else if (cb < 6784) {
            dst = (u16*)(ws + OFF_GB) + (size_t)row * 1024 + (col0 - 5760);
#pragma unroll
            for (int j = 0; j < 4; ++j) { v0[j] = siluf_(v0[j]); v1[j] = siluf_(v1[j]); }
          } else {
            dst = (u16*)out + (size_t)row * 2048 + (col0 - 6784);
#pragma unroll
            for (int j = 0; j < 4; ++j) { v0[j] = sigmoidf_(v0[j]); v1[j] = sigmoidf_(v1[j]); }
          }
          u32x4 w; w.x = cvt_pk_bf16(v0[0], v0[1]); w.y = cvt_pk_bf16(v0[2], v0[3]); w.z = cvt_pk_bf16(v1[0], v1[1]); w.w = cvt_pk_bf16(v1[2], v1[3]);
          *(u32x4*)dst = w;
        }
    }
  }
};
struct EpiMerge {
  static constexpr bool PERM = true, MID = true, AFTER_DRAIN = false;
  static constexpr int MIDT = 16;
  static constexpr int MF = 3;
  const u16* mamb; u16* merged;
  __device__ __forceinline__ void mid(f32x4 (&acc)[2][2][4][2], const Unit& u, int wr, int wc, int fr, int fq) const {
    int lz; asm volatile("v_mov_b32 %0, 0" : "=v"(lz));
    const int row0 = u.pm * (64 * MF) + wr * (16 * MF) + fr + lz, col0 = u.pn * BM + wc * 32 + 8 * fq;
#pragma unroll
    for (int ai = 0; ai < 2; ++ai)
#pragma unroll
      for (int m = 0; m < MF; ++m)
#pragma unroll
        for (int bj = 0; bj < 2; ++bj) {
          const u16* rp = mamb + (size_t)(row0 + ai * (32 * MF) + m * 16) * 2048 + col0 + bj * HALF;
          const u32x4 a = *(const u32x4*)rp, b = *(const u32x4*)(rp + 1024);
          f32x4 r0, r1;
#define RCPF(x) __builtin_amdgcn_rcpf(x)
          r0[0] = bflo(a.x) * RCPF(bflo(b.x)); r0[1] = bfhi(a.x) * RCPF(bfhi(b.x)); r0[2] = bflo(a.y) * RCPF(bflo(b.y)); r0[3] = bfhi(a.y) * RCPF(bfhi(b.y));
          r1[0] = bflo(a.z) * RCPF(bflo(b.z)); r1[1] = bfhi(a.z) * RCPF(bfhi(b.z)); r1[2] = bflo(a.w) * RCPF(bflo(b.w)); r1[3] = bfhi(a.w) * RCPF(bfhi(b.w));
          acc[ai][bj][m][0] *= r0;
          acc[ai][bj][m][1] *= r1;
          __builtin_amdgcn_sched_barrier(0);
        }
  }
  __device__ __forceinline__ void operator()(const f32x4 (&acc)[2][2][4][2], const Unit& u, int wr, int wc, int fr, int fq) const {
    const int row0 = u.pm * (64 * MF) + wr * (16 * MF) + fr, col0 = u.pn * BM + wc * 32 + 8 * fq;
#pragma unroll
    for (int ai = 0; ai < 2; ++ai)
#pragma unroll
      for (int m = 0; m < MF; ++m)
#pragma unroll
        for (int bj = 0; bj < 2; ++bj) {
          const size_t row = (size_t)(row0 + ai * (32 * MF) + m * 16);
          const u32x4 b = *(const u32x4*)(mamb + row * 2048 + 1024 + col0 + bj * HALF);
          const f32x4 v0 = acc[ai][bj][m][0], v1 = acc[ai][bj][m][1];
          u32x4 w;
          w.x = cvt_pk_bf16(v0[0] * bflo(b.x), v0[1] * bfhi(b.x)); w.y = cvt_pk_bf16(v0[2] * bflo(b.y), v0[3] * bfhi(b.y));
          w.z = cvt_pk_bf16(v1[0] * bflo(b.z), v1[1] * bfhi(b.z)); w.w = cvt_pk_bf16(v1[2] * bflo(b.w), v1[3] * bfhi(b.w));
          *(u32x4*)(merged + row * 1024 + col0 + bj * HALF) = w;
          __builtin_amdgcn_sched_barrier(0);
        }
  }
};
struct EpiOut {
  static constexpr bool PERM = false, MID = false, AFTER_DRAIN = true;
  static constexpr int MIDT = 0;
  static constexpr int MF = 3;
  const float *xp, *xs, *mod, *fnw; float* out; float* rsum; unsigned* pcnt;
  __device__ __forceinline__ void mid(f32x4 (&acc)[2][2][4][2], const Unit& u, int wr, int wc, int fr, int fq) const {}
  __device__ __forceinline__ void operator()(f32x4 (&acc)[2][2][4][2], const Unit& u, int wr, int wc, int fr, int fq) const {
    const int row0 = u.pm * (64 * MF) + wr * (16 * MF) + fr, col0 = u.pn * BM + wc * 32 + 4 * fq;
    {
#pragma unroll
      for (int ai = 0; ai < 2; ++ai)
#pragma unroll
        for (int m = 0; m < MF; ++m) {
          const int row = row0 + ai * (32 * MF) + m * 16;
          const float* xr = (row < NCTX) ? xp + (size_t)row * 1024 : xs + (size_t)(row - NCTX) * 1024;
          const float* gr = mod + ((row < NCTX) ? 4 : ((row - NCTX) >> 10)) * 3072 + 2048;
          float ss = 0.f;
#pragma unroll
          for (int bj = 0; bj < 2; ++bj)
#pragma unroll
            for (int n = 0; n < 2; ++n) {
              const f32x4 v = *(const f32x4*)(xr + col0 + bj * HALF + n * 16) + *(const f32x4*)(gr + col0 + bj * HALF + n * 16) * acc[ai][bj][m][n];
              acc[ai][bj][m][n] = v;
              ss += v[0] * v[0] + v[1] * v[1] + v[2] * v[2] + v[3] * v[3];
            }
          ss += __shfl_xor(ss, 16);
          ss += __shfl_xor(ss, 32);
          if (fq == 0) atomicAdd(rsum + row, ss);
        }
    }
    __syncthreads();
    if (threadIdx.x == 0) {
      __builtin_amdgcn_fence(__ATOMIC_RELEASE, "agent");
      asm volatile("s_waitcnt vmcnt(0)" ::: "memory");
      xb_add(pcnt + u.pm, 1u);
      unsigned sp = 0;
      while (xb_ld(pcnt + u.pm) < 4u) { __builtin_amdgcn_s_sleep(1); if (++sp > (1u << 22)) break; }
      __builtin_amdgcn_fence(__ATOMIC_ACQUIRE, "agent");
      asm volatile("s_waitcnt vmcnt(0)" ::: "memory");
    }
    __syncthreads();
    f32x4 w[2][2];
#pragma unroll
    for (int bj = 0; bj < 2; ++bj)
#pragma unroll
      for (int n = 0; n < 2; ++n) w[bj][n] = *(const f32x4*)(fnw + col0 + bj * HALF + n * 16);
#pragma unroll
    for (int ai = 0; ai < 2; ++ai)
#pragma unroll
      for (int m = 0; m < MF; ++m) {
        const int row = row0 + ai * (32 * MF) + m * 16;
        const float tot = __hip_atomic_load(rsum + row, __ATOMIC_RELAXED, __HIP_MEMORY_SCOPE_AGENT);
        const float rstd = rsqrtf(tot * (1.f / 1024.f) + 1e-6f);
        float* orow = out + (size_t)row * 1024;
#pragma unroll
        for (int bj = 0; bj < 2; ++bj)
#pragma unroll
          for (int n = 0; n < 2; ++n) *(f32x4*)(orow + col0 + bj * HALF + n * 16) = acc[ai][bj][m][n] * rstd * w[bj][n];
      }
  }
};

template <class Epi>
__device__ __forceinline__ void gemm_phase(LAS unsigned char* lds, const Gemm g, const StaticOrder& S, const Epi& E) {
  int tid = threadIdx.x;
  asm volatile("" : "+v"(tid));
  const int wid = __builtin_amdgcn_readfirstlane(tid >> 6), lane = tid & 63, wr = wid >> 2, wc = wid & 3, fr = lane & 15, fq = lane >> 4;
  const int nt = g.K / BK;
  unsigned voffA[2], voffB[2];
#pragma unroll
  for (int i = 0; i < 2; ++i) { int R, C; stage_rc(tid * 16 + i * 8192, R, C); const int Rb = Epi::PERM ? ((R & ~31) + perm32(R & 31)) : R;
    voffA[i] = (unsigned)(R * g.lda + C) * 2u; voffB[i] = (unsigned)(Rb * g.ldb + C) * 2u; }
  const size_t kstep = (size_t)(BK * 2);
  constexpr int MF = Epi::MF;
  const size_t hstepA = (size_t)(32 * MF) * g.lda * 2, hstepB = (size_t)HALF * g.ldb * 2;
  const size_t tstepA = 2 * hstepA, tstepB = 2 * hstepB;
  const unsigned ldsw = (unsigned)wid * 1024u;
  const int aoff = lds_byte(wr * (16 * MF) + fr, fq * 8), boff = lds_byte(wc * 32 + fr, fq * 8);
#define PG8_SA(b, h) (((b) * 2 + (h)) * HTB)
#define PG8_SB(b, h) ((4 + (b) * 2 + (h)) * HTB)
#define PG8_STAGE(bufoff, gbase, voff) do { _Pragma("unroll") for (int _i = 0; _i < 2; ++_i) \
    __builtin_amdgcn_global_load_lds((const unsigned*)((const char*)(gbase) + (voff)[_i]), (LAS unsigned*)(lds + (bufoff) + ldsw + _i * 8192), 16, 0, 0); } while (0)
#define PG8_LDA(dst, b, h) do { _Pragma("unroll") for (int m = 0; m < MF; ++m) _Pragma("unroll") for (int k = 0; k < 2; ++k) dst[m][k] = *(const LAS bf16x8*)(lds + PG8_SA(b, h) + aoff + m * 2048 + k * 1024); } while (0)
#define PG8_LDB(dst, b, h) do { _Pragma("unroll") for (int n = 0; n < 2; ++n) _Pragma("unroll") for (int k = 0; k < 2; ++k) dst[n][k] = *(const LAS bf16x8*)(lds + PG8_SB(b, h) + boff + n * 2048 + k * 1024); } while (0)
#define PG8_MMA(ai, bj, At, Bt) do { __builtin_amdgcn_s_setprio(1); _Pragma("unroll") for (int m = 0; m < MF; ++m) _Pragma("unroll") for (int n = 0; n < 2; ++n) _Pragma("unroll") for (int k = 0; k < 2; ++k) \
    acc[ai][bj][m][n] = __builtin_amdgcn_mfma_f32_16x16x32_bf16(Bt[n][k], At[m][k], acc[ai][bj][m][n], 0, 0, 0); __builtin_amdgcn_s_setprio(0); } while (0)
#define PG8_WAIT_V(n) asm volatile("s_waitcnt vmcnt(" #n ")" ::: "memory")
#define PG8_WAIT_L(n) asm volatile("s_waitcnt lgkmcnt(" #n ")" ::: "memory")
#define PG8_WAIT_LB do { if constexpr (MF == 4) PG8_WAIT_L(8); else PG8_WAIT_L(6); } while (0)
#define PG8_BAR __builtin_amdgcn_s_barrier()
#define PG8_SCHED __builtin_amdgcn_sched_barrier(0)
  Unit cur, nxt; int ui = 0;
  if (!S.next(0, cur)) return;
  f32x4 acc[2][2][4][2];
#pragma unroll
  for (int a = 0; a < 2; ++a)
#pragma unroll
    for (int b = 0; b < 2; ++b)
#pragma unroll
      for (int m = 0; m < 4; ++m)
#pragma unroll
        for (int n = 0; n < 2; ++n) acc[a][b][m][n] = (f32x4){0.f, 0.f, 0.f, 0.f};
  bf16x8 At[4][2], B0[2][2], B1[2][2];
  const char* cA = (const char*)g.A + (size_t)cur.pm * tstepA; const char* cB = (const char*)g.Bt + (size_t)cur.pn * tstepB;
  PG8_STAGE(PG8_SB(0, 0), cB, voffB); PG8_STAGE(PG8_SA(0, 0), cA, voffA); PG8_STAGE(PG8_SB(0, 1), cB + hstepB, voffB); PG8_STAGE(PG8_SA(0, 1), cA + hstepA, voffA);
  if (wr == 1) PG8_BAR;
  PG8_WAIT_V(4); PG8_BAR;
  PG8_STAGE(PG8_SB(1, 0), cB + kstep, voffB); PG8_STAGE(PG8_SA(1, 0), cA + kstep, voffA); PG8_STAGE(PG8_SB(1, 1), cB + hstepB + kstep, voffB);
  PG8_WAIT_V(6); PG8_BAR;
  for (;;) {
    const bool has_next = S.next(ui + 1, nxt);
    const char* nA = has_next ? (const char*)g.A + (size_t)nxt.pm * tstepA : cA; const char* nB = has_next ? (const char*)g.Bt + (size_t)nxt.pn * tstepB : cB;
    for (int t = 0; t < nt; t += 2) {
      const bool last = (t == nt - 2);
      const char* a1 = cA + (size_t)(t + 1) * kstep;
      const char* a2 = last ? nA : cA + (size_t)(t + 2) * kstep; const char* b2 = last ? nB : cB + (size_t)(t + 2) * kstep;
      const char* a3 = a2 + kstep; const char* b3 = b2 + kstep;
      if constexpr (Epi::MID) { if (t == Epi::MIDT) E.mid(acc, cur, wr, wc, fr, fq); }
      PG8_LDB(B0, 0, 0); PG8_SCHED; PG8_LDA(At, 0, 0); PG8_STAGE(PG8_SA(1, 1), a1 + hstepA, voffA);
      PG8_WAIT_LB; PG8_BAR; PG8_WAIT_L(0); PG8_MMA(0, 0, At, B0); PG8_BAR; PG8_SCHED;
      PG8_LDB(B1, 0, 1); PG8_STAGE(PG8_SB(0, 0), b2, voffB);
      PG8_BAR; PG8_WAIT_L(0); PG8_MMA(0, 1, At, B1); PG8_BAR;
      PG8_LDA(At, 0, 1); PG8_STAGE(PG8_SA(0, 0), a2, voffA);
      PG8_BAR; PG8_WAIT_L(0); PG8_MMA(1, 0, At, B0); PG8_BAR; PG8_SCHED;
      PG8_STAGE(PG8_SB(0, 1), b2 + hstepB, voffB);
      PG8_WAIT_V(6); PG8_BAR; PG8_MMA(1, 1, At, B1); PG8_BAR;
      PG8_LDB(B0, 1, 0); PG8_SCHED; PG8_LDA(At, 1, 0); PG8_STAGE(PG8_SA(0, 1), a2 + hstepA, voffA);
      PG8_WAIT_LB; PG8_BAR; PG8_WAIT_L(0); PG8_MMA(0, 0, At, B0); PG8_BAR; PG8_SCHED;
      PG8_LDB(B1, 1, 1); PG8_STAGE(PG8_SB(1, 0), b3, voffB);
      PG8_BAR; PG8_WAIT_L(0); PG8_MMA(0, 1, At, B1); PG8_BAR;
      PG8_LDA(At, 1, 1); PG8_STAGE(PG8_SA(1, 0), a3, voffA);
      PG8_BAR; PG8_WAIT_L(0); PG8_MMA(1, 0, At, B0); PG8_BAR; PG8_SCHED;
      PG8_STAGE(PG8_SB(1, 1), b3 + hstepB, voffB);
      PG8_WAIT_V(6); PG8_BAR; PG8_MMA(1, 1, At, B1); PG8_BAR;
    }
    if constexpr (!Epi::AFTER_DRAIN) E(acc, cur, wr, wc, fr, fq);
    if (!has_next) break;
#pragma unroll
    for (int a = 0; a < 2; ++a)
#pragma unroll
      for (int b = 0; b < 2; ++b)
#pragma unroll
        for (int m = 0; m < 4; ++m)
#pragma unroll
          for (int n = 0; n < 2; ++n) acc[a][b][m][n] = (f32x4){0.f, 0.f, 0.f, 0.f};
    cur = nxt; cA = nA; cB = nB; ++ui;
  }
  PG8_WAIT_V(0);
  if (wr == 0) PG8_BAR;
  PG8_BAR;
  if constexpr (Epi::AFTER_DRAIN) E(acc, cur, wr, wc, fr, fq);
#undef PG8_SA
#undef PG8_SB
#undef PG8_STAGE
#undef PG8_LDA
#undef PG8_LDB
#undef PG8_MMA
#undef PG8_WAIT_V
#undef PG8_WAIT_L
#undef PG8_WAIT_LB
#undef PG8_BAR
#undef PG8_SCHED
}

__device__ __forceinline__ void phase_conv(const Params& p) {
  const u16* ZA = (const u16*)(p.ws + OFF_ZA);
  u16* RC = (u16*)(p.ws + OFF_H);
  u16* KC = (u16*)(p.ws + OFF_KC);
  u16* VC = (u16*)(p.ws + OFF_VC);
  u16* WA = (u16*)(p.ws + OFF_WA);
  float* RN = (float*)(p.ws + OFF_RN);
  float* BD = (float*)(p.ws + OFF_BD);
  const int gt = blockIdx.x * NTHR + threadIdx.x, gs = gridDim.x * NTHR;
  {
    const int hi = gt & 127, h = hi >> 3, i = hi & 7;
    const int cbase = h * 64 + i * 8;
    float kkw[8], rkw[8];
#pragma unroll
    for (int e = 0; e < 8; ++e) { kkw[e] = p.k_k[cbase + e]; rkw[e] = p.r_k[cbase + e]; }
    float cw3[3][3][8];
#pragma unroll
    for (int sa = 0; sa < 3; ++sa)
#pragma unroll
      for (int tp = 0; tp < 3; ++tp)
#pragma unroll
        for (int e = 0; e < 8; ++e) cw3[sa][tp][e] = p.conv_a[tp * ZAW + sa * 1024 + cbase + e];
    for (int u = gt; u < (NTOK / 4) * 128; u += gs) {
      const int tok0 = (u >> 7) * 4;
      int t0, T;
      if (tok0 < NCTX) { t0 = tok0 & 255; T = 256; } else { t0 = (tok0 - NCTX) & 1023; T = 1024; }
      float res[3][4][8];
#pragma unroll
      for (int sa = 0; sa < 3; ++sa) {
        const int col = sa * 1024 + cbase;
        const bf16x8 z = {0, 0, 0, 0, 0, 0, 0, 0};
        bf16x8 rw[6];
#pragma unroll
        for (int q = 0; q < 6; ++q) {
          const bool ok = (q == 0) ? (t0 > 0) : ((q == 5) ? (t0 + 4 < T) : true);
          rw[q] = ok ? *(const bf16x8*)(ZA + (size_t)(tok0 - 1 + q) * ZAW + col) : z;
        }
#pragma unroll
        for (int i4 = 0; i4 < 4; ++i4)
#pragma unroll
          for (int e = 0; e < 8; ++e)
            res[sa][i4][e] = cw3[sa][0][e] * bf2f((u16)rw[i4][e]) + cw3[sa][1][e] * bf2f((u16)rw[i4 + 1][e]) + cw3[sa][2][e] * bf2f((u16)rw[i4 + 2][e]);
      }
#pragma unroll
      for (int i4 = 0; i4 < 4; ++i4) {
        const int tok = tok0 + i4;
        u32x4 o;
        o.x = cvt_pk_bf16(res[0][i4][0], res[0][i4][1]); o.y = cvt_pk_bf16(res[0][i4][2], res[0][i4][3]); o.z = cvt_pk_bf16(res[0][i4][4], res[0][i4][5]); o.w = cvt_pk_bf16(res[0][i4][6], res[0][i4][7]);
        *(u32x4*)(RC + (size_t)tok * 1024 + cbase) = o;
        o.x = cvt_pk_bf16(res[1][i4][0], res[1][i4][1]); o.y = cvt_pk_bf16(res[1][i4][2], res[1][i4][3]); o.z = cvt_pk_bf16(res[1][i4][4], res[1][i4][5]); o.w = cvt_pk_bf16(res[1][i4][6], res[1][i4][7]);
        *(u32x4*)(KC + (size_t)tok * 1024 + cbase) = o;
        o.x = cvt_pk_bf16(res[2][i4][0], res[2][i4][1]); o.y = cvt_pk_bf16(res[2][i4][2], res[2][i4][3]); o.z = cvt_pk_bf16(res[2][i4][4], res[2][i4][5]); o.w = cvt_pk_bf16(res[2][i4][6], res[2][i4][7]);
        *(u32x4*)(VC + (size_t)tok * 1024 + cbase) = o;
        float ss = 0, bd = 0;
#pragma unroll
        for (int e = 0; e < 8; ++e) {
          float kk = res[1][i4][e] * kkw[e];
          ss += kk * kk;
          bd += res[0][i4][e] * res[1][i4][e] * rkw[e];
        }
        ss = red8(ss);
        bd = red8(bd);
        if (i == 0) {
          RN[tok * 16 + h] = rsqrtf(fmaxf(ss, 1e-12f));
          BD[tok * 16 + h] = bd;
        }
      }
    }
  }
  for (int u = gt; u < NTOK * 16; u += gs) {
    const int tok = u >> 4, jv = u & 15;
    int t, T;
    if (tok < NCTX) { t = tok & 255; T = 256; } else { t = (tok - NCTX) & 1023; T = 1024; }
    const int col = 3072 + jv * 8;
    bf16x8 z = {0, 0, 0, 0, 0, 0, 0, 0};
    bf16x8 c1 = *(const bf16x8*)(ZA + (size_t)tok * ZAW + col);
    bf16x8 c0 = (t > 0) ? *(const bf16x8*)(ZA + (size_t)(tok - 1) * ZAW + col) : z;
    bf16x8 c2 = (t < T - 1) ? *(const bf16x8*)(ZA + (size_t)(tok + 1) * ZAW + col) : z;
    bf16x8 o;
#pragma unroll
    for (int e = 0; e < 8; ++e) {
      float w0 = p.conv_a[col + e], w1 = p.conv_a[ZAW + col + e], w2 = p.conv_a[2 * ZAW + col + e];
      float r = w0 * bf2f((u16)c0[e]) + w1 * bf2f((u16)c1[e]) + w2 * bf2f((u16)c2[e]);
      if (jv < 8) r = tanhf(r);
      o[e] = (short)f2bf(r);
    }
    *(bf16x8*)(WA + (size_t)tok * 128 + jv * 8) = o;
  }
  {
    const float* rcos = (const float*)(p.ws + OFF_ROPE);
    const float* rsin = rcos + 1024;
    const u16* KL = (const u16*)(p.ws + OFF_KL);
    for (int u = gt; u < 425984; u += gs) {
      bf16x8 o;
      if (u < 294912) {
        const bool isc = u < 262144;
        const int v = isc ? u : u - 262144;
        const float* src = (isc ? p.out + OUT_NEWK : p.cache_k) + (size_t)v * 8;
        const float4 a = *(const float4*)src, b4 = *(const float4*)(src + 4);
        u32x4 w; w.x = cvt_pk_bf16(a.x, a.y); w.y = cvt_pk_bf16(a.z, a.w); w.z = cvt_pk_bf16(b4.x, b4.y); w.w = cvt_pk_bf16(b4.z, b4.w);
        *(u32x4*)((u16*)(p.ws + (isc ? OFF_KBC : OFF_KBK)) + (size_t)v * 8) = w;
      } else {
        const int v = u - 294912, d8 = (v & 7) * 8, row = v >> 3;
        const int t = row & 1023, bh = row >> 10, b = bh >> 2, hk = bh & 3;
        const size_t rowo = ((size_t)b * 1024 + t) * 256 + hk * 64;
        const bf16x8 x = *(const bf16x8*)(KL + rowo + d8);
        const bf16x8 xp = *(const bf16x8*)(KL + rowo + (d8 ^ 16));
        const int pos = (d8 >= 32) ? (t & 63) : (t >> 6);
        const bool lo = (d8 & 16) == 0;
#pragma unroll
        for (int e = 0; e < 8; ++e) {
          const int i = (d8 & 8) + e;
          const float cs = rcos[pos * 16 + i], sn = rsin[pos * 16 + i];
          const float a = bf2f((u16)x[e]), bpart = bf2f((u16)xp[e]);
          o[e] = (short)f2bf(lo ? (a * cs - bpart * sn) : (bpart * sn + a * cs));
        }
        *(bf16x8*)((u16*)(p.ws + OFF_KBL) + (size_t)row * 64 + d8) = o;
      }
    }
    const u16* VL = (const u16*)(p.ws + OFF_VL);
    float* sm = (float*)smem_raw;
    const int tid = threadIdx.x;
    for (int it = blockIdx.x; it < 832; it += gridDim.x) {
      const int key = tid >> 3, d8 = (tid & 7) * 8;
      float f[8];
      u16* dst;
      int Tk, t0;
      if (it < 576) {
        const bool isc = it < 512;
        const int v = isc ? it : it - 512, bh = v >> 2;
        t0 = (v & 3) * 64; Tk = 256;
        const float* src = (isc ? p.out + OUT_NEWV : p.cache_v) + ((size_t)bh * 256 + t0 + key) * 64 + d8;
        const float4 a = *(const float4*)src, b4 = *(const float4*)(src + 4);
        f[0] = a.x; f[1] = a.y; f[2] = a.z; f[3] = a.w; f[4] = b4.x; f[5] = b4.y; f[6] = b4.z; f[7] = b4.w;
        dst = (u16*)(p.ws + (isc ? OFF_VTC : OFF_VTK)) + (size_t)bh * 64 * 256;
      } else {
        const int v = it - 576, bh = v >> 4, b = bh >> 2, hk = bh & 3;
        t0 = (v & 15) * 64; Tk = 1024;
        const bf16x8 x = *(const bf16x8*)(VL + ((size_t)b * 1024 + t0 + key) * 256 + hk * 64 + d8);
#pragma unroll
        for (int e = 0; e < 8; ++e) f[e] = bf2f((u16)x[e]);
        dst = (u16*)(p.ws + OFF_VTL) + (size_t)bh * 64 * 1024;
      }
#pragma unroll
      for (int e = 0; e < 8; ++e) sm[key * 65 + d8 + e] = f[e];
      __syncthreads();
      {
        const int d = tid >> 3, k8 = (tid & 7) * 8;
        u32x4 w;
        w.x = cvt_pk_bf16(sm[(k8 + 0) * 65 + d], sm[(k8 + 1) * 65 + d]); w.y = cvt_pk_bf16(sm[(k8 + 2) * 65 + d], sm[(k8 + 3) * 65 + d]);
        w.z = cvt_pk_bf16(sm[(k8 + 4) * 65 + d], sm[(k8 + 5) * 65 + d]); w.w = cvt_pk_bf16(sm[(k8 + 6) * 65 + d], sm[(k8 + 7) * 65 + d]);
        *(u32x4*)(dst + (size_t)d * Tk + t0 + k8) = w;
      }
      __syncthreads();
    }
  }
}


constexpr int S3_AH = 0, S3_RH = 2304, S3_VT = 4608, S3_BKT = 7680, S3_D15 = 12800, SET3_B = 13056;
constexpr int S2_BH = 0, S2_KH = 2304, SET2_B = 4608;
constexpr int G_ABF = 0, G_ABO = 256, G_AKH = 1024, G_RBH = 1792, G_RKH = 2560, GRAM_B = 3584;
constexpr int O_SET3 = 0, O_SET2 = 3 * SET3_B, O_GRAM = O_SET2 + 2 * SET2_B, O_YB = O_GRAM + 2 * GRAM_B;
constexpr int CH_BYTES = O_YB + 2 * 4096;
static_assert(2 * CH_BYTES <= 131072, "scan LDS overflow");

__device__ __forceinline__ bf16x8 pack8(uint2 lo, uint2 hi) {
  u32x4 t = {lo.x, lo.y, hi.x, hi.y};
  return __builtin_bit_cast(bf16x8, t);
}
#define LDSBAR() do { asm volatile("s_waitcnt lgkmcnt(0)" ::: "memory"); __builtin_amdgcn_s_barrier(); asm volatile("" ::: "memory"); } while (0)

struct ScanK {
  const u16 *RC, *KC, *VC, *WA;
  const float* RN;
  unsigned oWA, oRC, oRN;
  u16* Y;
  const u16* Yo;
  const float* BD;
  u16* GA;
  int d, cw, fr, fq, kcol, ch, h, ctid;
  float w0v, a0v, kkc, kac;
  float lw[4], lb[4];
};
struct ScanPre { bf16x8 paw[2], paa[2]; u16 prc[4], pkc[4], pvc[4]; float prn[4]; };

template <int D>
__device__ __forceinline__ void scan_load(ScanK& k, ScanPre& r) {
#pragma unroll
  for (int ks = 0; ks < 2; ++ks) {
    r.paw[ks] = *(const bf16x8*)(k.WA + k.oWA + ks * 32);
    r.paa[ks] = *(const bf16x8*)(k.WA + k.oWA + 64 + ks * 32);
  }
#pragma unroll
  for (int j = 0; j < 4; ++j) {
    r.prc[j] = k.RC[k.oRC + j * 1024]; r.pkc[j] = k.KC[k.oRC + j * 1024]; r.pvc[j] = k.VC[k.oRC + j * 1024];
    r.prn[j] = k.RN[k.oRN + j * 16];
  }
  if (D) { k.oWA -= 16 * 128; k.oRC -= 16 * 1024; k.oRN -= 16 * 16; }
  else { k.oWA += 16 * 128; k.oRC += 16 * 1024; k.oRN += 16 * 16; }
}

template <int D>
__device__ __forceinline__ void scan_s0(const ScanK& k, const ScanPre& r, const bf16x8 (&bw)[2], const bf16x8 (&ba)[2], char* set3, char* set2) {
  u16* AH = (u16*)(set3 + S3_AH); u16* RH = (u16*)(set3 + S3_RH); u16* VT = (u16*)(set3 + S3_VT); u16* BKT = (u16*)(set3 + S3_BKT);
  float* D15 = (float*)(set3 + S3_D15);
  u16* BH = (u16*)(set2 + S2_BH); u16* KH = (u16*)(set2 + S2_KH);
  constexpr int d = D;
  const int fq = k.fq, fr = k.fr, kcol = k.kcol;
  f32x4 accw = {0, 0, 0, 0}, acca = {0, 0, 0, 0};
#pragma unroll
  for (int ks = 0; ks < 2; ++ks) {
    accw = __builtin_amdgcn_mfma_f32_16x16x32_bf16(r.paw[ks], bw[ks], accw, 0, 0, 0);
    acca = __builtin_amdgcn_mfma_f32_16x16x32_bf16(r.paa[ks], ba[ks], acca, 0, 0, 0);
  }
  float fa[4], fb[4], fk[4], frr[4], fw[4], fv[4];
#pragma unroll
  for (int j = 0; j < 4; ++j) {
    const float rc = bf2f(r.prc[j]), kc = bf2f(r.pkc[j]);
    fv[j] = bf2f(r.pvc[j]);
    const float e = 0.60653066f * sigmoidf_(k.w0v + accw[j]);
    fw[j] = __expf(-e);
    const float av = sigmoidf_(k.a0v + acca[j]);
    const float kkv = kc * k.kkc * r.prn[j];
    fa[j] = -kkv; fb[j] = kkv * av; fk[j] = kc * (1.f + (av - 1.f) * k.kac); frr[j] = rc;
  }
  float ER[4], EA[4];
  if (d == 0) { ER[0] = fw[0]; ER[1] = ER[0] * fw[1]; ER[2] = ER[1] * fw[2]; ER[3] = ER[2] * fw[3]; }
  else { ER[3] = fw[3]; ER[2] = ER[3] * fw[2]; ER[1] = ER[2] * fw[1]; ER[0] = ER[1] * fw[0]; }
  const float tot = d ? ER[0] : ER[3];
  const float g0 = __shfl(tot, fr), g1 = __shfl(tot, fr + 16), g2 = __shfl(tot, fr + 32), g3 = __shfl(tot, fr + 48);
  const float D15v = (g0 * g1) * (g2 * g3);
  float off;
  if (d == 0) off = (fq > 0 ? g0 : 1.f) * (fq > 1 ? g1 : 1.f) * (fq > 2 ? g2 : 1.f);
  else off = (fq < 3 ? g3 : 1.f) * (fq < 2 ? g2 : 1.f) * (fq < 1 ? g1 : 1.f);
#pragma unroll
  for (int j = 0; j < 4; ++j) ER[j] *= off;
  if (d == 0) { EA[0] = off; EA[1] = ER[0]; EA[2] = ER[1]; EA[3] = ER[2]; }
  else { EA[3] = off; EA[2] = ER[3]; EA[1] = ER[2]; EA[0] = ER[1]; }
  float btv[4], ktv[4];
#pragma unroll
  for (int j = 0; j < 4; ++j) {
    const int tkn = fq * 4 + j, jj = d ? 15 - tkn : tkn;
    const float inv = __builtin_amdgcn_rcpf(ER[j]), EE = inv * D15v;
    const unsigned p1 = cvt_pk_bf16(fa[j] * EA[j], frr[j] * ER[j]);
    const unsigned p2 = cvt_pk_bf16(fb[j] * inv, fk[j] * inv);
    AH[jj * 72 + kcol] = (u16)(p1 & 0xffffu);
    RH[jj * 72 + kcol] = (u16)(p1 >> 16);
    BH[jj * 72 + kcol] = (u16)(p2 & 0xffffu);
    KH[jj * 72 + kcol] = (u16)(p2 >> 16);
    btv[j] = fb[j] * EE;
    ktv[j] = fk[j] * EE;
  }
  const int jj0 = d ? 12 - fq * 4 : fq * 4;
  uint2 pb, pk, pv;
  if (d == 0) {
    pb.x = cvt_pk_bf16(btv[0], btv[1]); pb.y = cvt_pk_bf16(btv[2], btv[3]);
    pk.x = cvt_pk_bf16(ktv[0], ktv[1]); pk.y = cvt_pk_bf16(ktv[2], ktv[3]);
    pv.x = cvt_pk_bf16(fv[0], fv[1]); pv.y = cvt_pk_bf16(fv[2], fv[3]);
  } else {
    pb.x = cvt_pk_bf16(btv[3], btv[2]); pb.y = cvt_pk_bf16(btv[1], btv[0]);
    pk.x = cvt_pk_bf16(ktv[3], ktv[2]); pk.y = cvt_pk_bf16(ktv[1], ktv[0]);
    pv.x = cvt_pk_bf16(fv[3], fv[2]); pv.y = cvt_pk_bf16(fv[1], fv[0]);
  }
  *(uint2*)(BKT + kcol * 40 + jj0) = pb;
  *(uint2*)(BKT + kcol * 40 + 16 + jj0) = pk;
  *(uint2*)(VT + kcol * 24 + jj0) = pv;
  if (fq == 0) D15[kcol] = D15v;
}

__device__ __forceinline__ void scan_s3(const ScanK& k, const char* set3, const char* set2, char* gram) {
  const int cw = k.cw, fr = k.fr, fq = k.fq;
  const u16* Asrc = (const u16*)(set3 + ((cw < 2) ? S3_AH : S3_RH));
  const u16* Bsrc = (const u16*)(set2 + ((cw & 1) ? S2_KH : S2_BH));
  float* ABF = (float*)(gram + G_ABF);
  u16* ABO = (u16*)(gram + G_ABO); u16* AKH = (u16*)(gram + G_AKH); u16* RBH = (u16*)(gram + G_RBH); u16* RKH = (u16*)(gram + G_RKH);
  f32x4 g = {0, 0, 0, 0};
#pragma unroll
  for (int ks = 0; ks < 2; ++ks) {
    bf16x8 af = *(const bf16x8*)(Asrc + fr * 72 + ks * 32 + fq * 8);
    bf16x8 bf_ = *(const bf16x8*)(Bsrc + fr * 72 + ks * 32 + fq * 8);
    g = __builtin_amdgcn_mfma_f32_16x16x32_bf16(af, bf_, g, 0, 0, 0);
  }
  u16* dstw = ABO + cw * 384;
  const int incl = cw >> 1;
  const bool samebk = (cw == 0) && ((fr >> 2) == fq);
#pragma unroll
  for (int j = 0; j < 4; ++j) {
    const int jrow = fq * 4 + j;
    const float val = (fr < jrow + incl) ? g[j] : 0.f;
    dstw[jrow * 24 + fr] = samebk ? (u16)0 : f2bf(val);
    if (samebk) ABF[jrow * 4 + (fr & 3)] = val;
  }
  (void)AKH; (void)RBH; (void)RKH;
}

template <int D>
__device__ __forceinline__ void scan_s5(const ScanK& k, f32x4 (&Zt)[4], const char* set3, const char* gram, float* YB) {
  const u16* AH = (const u16*)(set3 + S3_AH); const u16* RH = (const u16*)(set3 + S3_RH); const u16* VT = (const u16*)(set3 + S3_VT);
  const u16* BKT = (const u16*)(set3 + S3_BKT); const float* D15 = (const float*)(set3 + S3_D15);
  const float* ABF = (const float*)(gram + G_ABF);
  const u16* ABO = (const u16*)(gram + G_ABO); const u16* AKH = (const u16*)(gram + G_AKH); const u16* RBH = (const u16*)(gram + G_RBH); const u16* RKH = (const u16*)(gram + G_RKH);
  constexpr int d = D;
  const int fr = k.fr, fq = k.fq, kcol = k.kcol;
  const uint2 z2 = make_uint2(0u, 0u);
  bf16x8 zb[2];
#pragma unroll
  for (int ks = 0; ks < 2; ++ks) {
    uint2 lo, hi;
    lo.x = cvt_pk_bf16(Zt[2 * ks][0], Zt[2 * ks][1]); lo.y = cvt_pk_bf16(Zt[2 * ks][2], Zt[2 * ks][3]);
    hi.x = cvt_pk_bf16(Zt[2 * ks + 1][0], Zt[2 * ks + 1][1]); hi.y = cvt_pk_bf16(Zt[2 * ks + 1][2], Zt[2 * ks + 1][3]);
    zb[ks] = pack8(lo, hi);
  }
  const uint2 vv8 = *(const uint2*)(VT + kcol * 24 + fq * 4);
  f32x4 accX = {0, 0, 0, 0}, accY = {0, 0, 0, 0};
  accX = __builtin_amdgcn_mfma_f32_16x16x16bf16_1k(__builtin_bit_cast(bf16x4, *(const uint2*)(AKH + fr * 24 + fq * 4)), __builtin_bit_cast(bf16x4, vv8), accX, 0, 0, 0);
#pragma unroll
  for (int ks = 0; ks < 2; ++ks) {
    bf16x8 aA = pack8(*(const uint2*)(AH + fr * 72 + (2 * ks) * 16 + fq * 4), *(const uint2*)(AH + fr * 72 + (2 * ks + 1) * 16 + fq * 4));
    bf16x8 aR = pack8(*(const uint2*)(RH + fr * 72 + (2 * ks) * 16 + fq * 4), *(const uint2*)(RH + fr * 72 + (2 * ks + 1) * 16 + fq * 4));
    accX = __builtin_amdgcn_mfma_f32_16x16x32_bf16(aA, zb[ks], accX, 0, 0, 0);
    accY = __builtin_amdgcn_mfma_f32_16x16x32_bf16(aR, zb[ks], accY, 0, 0, 0);
  }
  uint2 s2 = z2;
  {
    const float4 d1 = *(const float4*)(ABF + (fq * 4 + 1) * 4), d2 = *(const float4*)(ABF + (fq * 4 + 2) * 4), d3 = *(const float4*)(ABF + (fq * 4 + 3) * 4);
    const bf16x4 aAb = __builtin_bit_cast(bf16x4, *(const uint2*)(ABO + fr * 24 + fq * 4));
    const float T10 = d1.x, T21 = d2.y, T32 = d3.z;
    const float T20 = d2.x + d2.y * d1.x;
    const float T31 = d3.y + d3.z * d2.y;
    const float T30 = d3.x + d3.y * d1.x + d3.z * T20;
    f32x4 accS = accX;
#pragma unroll
    for (int q = 0; q < 4; ++q) {
      const float t0 = accS[0];
      const float t1 = accS[1] + T10 * t0;
      const float t2 = accS[2] + T20 * t0 + T21 * accS[1];
      const float t3 = accS[3] + T30 * t0 + T31 * accS[1] + T32 * accS[2];
      uint2 pk;
      pk.x = cvt_pk_bf16(t0, t1); pk.y = cvt_pk_bf16(t2, t3);
      if (fq == q) s2 = pk;
      if (q < 3) {
        const uint2 m = (fq == q) ? pk : z2;
        accS = __builtin_amdgcn_mfma_f32_16x16x16bf16_1k(aAb, __builtin_bit_cast(bf16x4, m), accS, 0, 0, 0);
      }
    }
  }
  const bf16x8 sb = pack8(s2, vv8);
  accY = __builtin_amdgcn_mfma_f32_16x16x32_bf16(pack8(*(const uint2*)(RBH + fr * 24 + fq * 4), *(const uint2*)(RKH + fr * 24 + fq * 4)), sb, accY, 0, 0, 0);
#pragma unroll
  for (int j = 0; j < 4; ++j) {
    const int jrow = fq * 4 + j, tkn = d ? 15 - jrow : jrow;
    YB[tkn * 64 + kcol] = accY[j];
  }
#pragma unroll
  for (int kt = 0; kt < 4; ++kt) {
    const float4 dd = *(const float4*)(D15 + kt * 16 + fq * 4);
    f32x4 z = Zt[kt];
    z[0] *= dd.x; z[1] *= dd.y; z[2] *= dd.z; z[3] *= dd.w;
    const u16* bk = BKT + (kt * 16 + fr) * 40 + fq * 4;
    Zt[kt] = __builtin_amdgcn_mfma_f32_16x16x32_bf16(pack8(*(const uint2*)bk, *(const uint2*)(bk + 16)), sb, z, 0, 0, 0);
  }
}

__device__ __forceinline__ void scan_flush(const ScanK& k, const float* YB, int tb, bool second) {
  const int tkn = k.ctid >> 4, k4 = (k.ctid & 15) * 4;
  const float4 yv = *(const float4*)(YB + tkn * 64 + k4);
  const size_t tok = (size_t)(tb + tkn);
  if (!second) {
    uint2 o;
    o.x = cvt_pk_bf16(yv.x, yv.y);
    o.y = cvt_pk_bf16(yv.z, yv.w);
    *(uint2*)(k.Y + tok * 1024 + k.h * 64 + k4) = o;
  } else {
    const uint2 yo = *(const uint2*)(k.Yo + tok * 1024 + k.h * 64 + k4);
    const uint2 vc = *(const uint2*)(k.VC + tok * 1024 + k.h * 64 + k4);
    u16* gp = k.GA + tok * 2048 + k.h * 64 + k4;
    const uint2 ga = *(const uint2*)gp;
    const float bd = k.BD[tok * 16 + k.h];
    const float y0 = yv.x + bflo(yo.x), y1 = yv.y + bfhi(yo.x), y2 = yv.z + bflo(yo.y), y3 = yv.w + bfhi(yo.y);
    const float s1 = red16(y0 + y1 + y2 + y3);
    const float s2 = red16(y0 * y0 + y1 * y1 + y2 * y2 + y3 * y3);
    const float mu = s1 * (1.f / 64.f);
    const float var = fmaxf(s2 * (1.f / 64.f) - mu * mu, 0.f);
    const float rstd = rsqrtf(var + 64e-5f);
    const float o0 = ((y0 - mu) * rstd * k.lw[0] + k.lb[0] + bd * bflo(vc.x)) * bflo(ga.x);
    const float o1 = ((y1 - mu) * rstd * k.lw[1] + k.lb[1] + bd * bfhi(vc.x)) * bfhi(ga.x);
    const float o2 = ((y2 - mu) * rstd * k.lw[2] + k.lb[2] + bd * bflo(vc.y)) * bflo(ga.y);
    const float o3 = ((y3 - mu) * rstd * k.lw[3] + k.lb[3] + bd * bfhi(vc.y)) * bfhi(ga.y);
    uint2 o;
    o.x = cvt_pk_bf16(o0, o1);
    o.y = cvt_pk_bf16(o2, o3);
    *(uint2*)gp = o;
  }
}

template <int D>
__device__ __forceinline__ void scan_chain(const Params& p, bool latent, int idx, int tid) {
  const int lane = tid & 63;
  const int b = idx >> 4;
  ScanK k;
  k.d = D; k.ctid = tid & 255; k.cw = __builtin_amdgcn_readfirstlane((tid >> 6) & 3); k.fr = lane & 15; k.fq = lane >> 4; k.h = idx & 15;
  k.kcol = 16 * k.cw + k.fr; k.ch = k.h * 64 + k.kcol;
  constexpr int d = D;
  const int ch = k.ch;
  const int T = latent ? 1024 : 256;
  const int tok0 = latent ? NCTX + b * 1024 : b * 256;
  char* cs = smem_raw + d * CH_BYTES;
  k.RC = (const u16*)(p.ws + OFF_H); k.KC = (const u16*)(p.ws + OFF_KC); k.VC = (const u16*)(p.ws + OFF_VC);
  k.WA = (const u16*)(p.ws + OFF_WA); k.RN = (const float*)(p.ws + OFF_RN);
  {
    const int tb0 = tok0 + (D ? (T >> 4) - 1 : 0) * 16;
    k.oWA = (unsigned)((tb0 + k.fr) * 128 + k.fq * 8);
    k.oRC = (unsigned)((tb0 + k.fq * 4) * 1024 + ch);
    k.oRN = (unsigned)((tb0 + k.fq * 4) * 16 + k.h);
  }
  k.Y = (u16*)(p.ws + OFF_ZA + (size_t)d * SZ_ACT);
  k.Yo = (const u16*)(p.ws + OFF_ZA + (size_t)(1 - d) * SZ_ACT);
  k.BD = (const float*)(p.ws + OFF_BD);
  k.GA = (u16*)(p.ws + OFF_AQ);
#pragma unroll
  for (int e = 0; e < 4; ++e) { k.lw[e] = p.ln_w[k.h * 64 + (k.ctid & 15) * 4 + e]; k.lb[e] = p.ln_b[k.h * 64 + (k.ctid & 15) * 4 + e]; }
  k.w0v = p.w0[d * 1024 + ch]; k.a0v = p.a0[d * 1024 + ch]; k.kkc = p.k_k[ch]; k.kac = p.k_a[ch];
  bf16x8 bw[2], ba[2];
#pragma unroll
  for (int ks = 0; ks < 2; ++ks)
#pragma unroll
    for (int e = 0; e < 8; ++e) {
      int l = ks * 32 + k.fq * 8 + e;
      bw[ks][e] = (short)f2bf(p.w_up[(size_t)(d * 64 + l) * 1024 + ch]);
      ba[ks][e] = (short)f2bf(p.a_up[(size_t)(d * 64 + l) * 1024 + ch]);
    }
  f32x4 Zt[4];
  if (latent) {
    const float* s0 = p.state + ((size_t)(b * 2 + d) * 16 + k.h) * 4096 + k.kcol * 64 + k.fq * 4;
#pragma unroll
    for (int kt = 0; kt < 4; ++kt) Zt[kt] = *(const f32x4*)(s0 + kt * 16);
  } else {
#pragma unroll
    for (int kt = 0; kt < 4; ++kt) Zt[kt] = (f32x4){0.f, 0.f, 0.f, 0.f};
  }
  const int nc = T >> 4;
#define TB(c) (tok0 + (d ? nc - 1 - (c) : (c)) * 16)
#define SET3(c) (cs + O_SET3 + ((c) % 3) * SET3_B)
#define SET2(c) (cs + O_SET2 + ((c) & 1) * SET2_B)
#define GRAM(c) (cs + O_GRAM + ((c) & 1) * GRAM_B)
#define YBUF(c) ((float*)(cs + O_YB + ((c) & 1) * 4096))
  ScanPre r;
  scan_load<D>(k, r);
  scan_s0<D>(k, r, bw, ba, SET3(0), SET2(0));
  scan_load<D>(k, r);
  LDSBAR();
  scan_s3(k, SET3(0), SET2(0), GRAM(0));
  scan_s0<D>(k, r, bw, ba, SET3(1), SET2(1));
  scan_load<D>(k, r);
  LDSBAR();
  const int hc = nc >> 1;
  int m3 = 0;
  for (int i = 0; i < nc - 2; ++i) {
    const int m3b = (m3 == 2) ? 0 : m3 + 1, m3c = (m3b == 2) ? 0 : m3b + 1;
    if (i > 0) scan_flush(k, YBUF(i - 1), TB(i - 1), (i - 1) >= hc);
    scan_s5<D>(k, Zt, cs + O_SET3 + m3 * SET3_B, GRAM(i), YBUF(i));
    scan_s3(k, cs + O_SET3 + m3b * SET3_B, SET2(i + 1), GRAM(i + 1));
    scan_s0<D>(k, r, bw, ba, cs + O_SET3 + m3c * SET3_B, SET2(i));
    if (i + 3 < nc) scan_load<D>(k, r);
    if (i == hc) asm volatile("s_waitcnt vmcnt(0)" ::: "memory");
    LDSBAR();
    m3 = m3b;
  }
  {
    const int i = nc - 2;
    scan_flush(k, YBUF(i - 1), TB(i - 1), true);
    scan_s5<D>(k, Zt, SET3(i), GRAM(i), YBUF(i));
    scan_s3(k, SET3(i + 1), SET2(i + 1), GRAM(i + 1));
    LDSBAR();
  }
  {
    const int i = nc - 1;
    scan_flush(k, YBUF(i - 1), TB(i - 1), true);
    scan_s5<D>(k, Zt, SET3(i), GRAM(i), YBUF(i));
    LDSBAR();
    scan_flush(k, YBUF(i), TB(i), true);
  }
#undef TB
#undef SET3
#undef SET2
#undef GRAM
#undef YBUF
  if (!latent) {
    float* so = p.out + OUT_STATE + ((size_t)(b * 2 + d) * 16 + k.h) * 4096 + k.kcol * 64 + k.fq * 4;
#pragma unroll
    for (int kt = 0; kt < 4; ++kt) *(f32x4*)(so + kt * 16) = Zt[kt];
  }
  __syncthreads();
}

__device__ __forceinline__ void scan_item(const Params& p, bool latent, int idx) {
  int tid = threadIdx.x;
  asm volatile("" : "+v"(tid));
  if (__builtin_amdgcn_readfirstlane(tid >> 8)) scan_chain<1>(p, latent, idx, tid);
  else scan_chain<0>(p, latent, idx, tid);
  __syncthreads();
}

constexpr int KST = 72;
constexpr int ATT_BUF = 2 * 64 * KST * 2;

__device__ __forceinline__ void attn_item(const Params& p, bool latent, int idx) {
  int tid = threadIdx.x;
  asm volatile("" : "+v"(tid));
  const int w = __builtin_amdgcn_readfirstlane(tid >> 6), lane = tid & 63, fr = lane & 15, fq = lane >> 4;
  int b, head, qb;
  if (latent) { b = idx >> 6; head = (idx >> 2) & 15; qb = idx & 3; }
  else { b = idx >> 4; head = idx & 15; qb = 0; }
  const int hk = head >> 2;
  u16* Q = (u16*)(p.ws + OFF_AQ) + 1024;
  const u16* GB = (const u16*)(p.ws + OFF_GB);
  const float* rcos = (const float*)(p.ws + OFF_ROPE);
  const float* rsin = rcos + 1024;
  int qpos[2];
  size_t qtok[2];
  bf16x8 qf[2][2];
#pragma unroll
  for (int qt = 0; qt < 2; ++qt) {
    qpos[qt] = qb * 256 + w * 32 + qt * 16 + fr;
    qtok[qt] = latent ? (size_t)NCTX + b * 1024 + qpos[qt] : (size_t)b * 256 + qpos[qt];
#pragma unroll
    for (int ks = 0; ks < 2; ++ks) {
      bf16x8 x = *(const bf16x8*)(Q + qtok[qt] * 2048 + head * 64 + ks * 32 + fq * 8);
      if (latent) {
        bf16x8 xp = *(const bf16x8*)(Q + qtok[qt] * 2048 + head * 64 + ks * 32 + (fq ^ 2) * 8);
        const int pos = ks ? (qpos[qt] & 63) : (qpos[qt] >> 6);
#pragma unroll
        for (int e = 0; e < 8; ++e) {
          int i = (fq & 1) * 8 + e;
          float cs = rcos[pos * 16 + i], sn = rsin[pos * 16 + i];
          float a = bf2f((u16)x[e]), bpart = bf2f((u16)xp[e]);
          float o = (fq < 2) ? (a * cs - bpart * sn) : (bpart * sn + a * cs);
          x[e] = (short)f2bf(o);
        }
      }
      qf[qt][ks] = x;
    }
  }
  float m_run[2], l_run[2];
  f32x4 ot[2][4];
#pragma unroll
  for (int qt = 0; qt < 2; ++qt) {
    m_run[qt] = p.sink[head]; l_run[qt] = 1.f;
#pragma unroll
    for (int dt = 0; dt < 4; ++dt) ot[qt][dt] = (f32x4){0, 0, 0, 0};
  }
  int lt0 = 0, nloc = 0;
  if (latent) {
    int ks0 = qb * 256 - 128; if (ks0 < 0) ks0 = 0;
    int ke = qb * 256 + 384; if (ke > 1024) ke = 1024;
    lt0 = ks0 >> 6; nloc = (ke >> 6) - lt0;
  }
  const int ntile = nloc + 4;
  const int wq_lo = qb * 256 + w * 32, wq_hi = wq_lo + 31;
  const u16* KBloc = (const u16*)(p.ws + OFF_KBL) + (size_t)(b * 4 + hk) * 1024 * 64;
  const u16* VTloc = (const u16*)(p.ws + OFF_VTL) + (size_t)(b * 4 + hk) * 64 * 1024;
  const u16* KBctx = (const u16*)(p.ws + (latent ? OFF_KBK : OFF_KBC)) + (size_t)(b * 4 + hk) * 256 * 64;
  const u16* VTctx = (const u16*)(p.ws + (latent ? OFF_VTK : OFF_VTC)) + (size_t)(b * 4 + hk) * 64 * 256;
  const int lrow = tid >> 3, lc8 = (tid & 7) * 8;
  bf16x8 kreg, vreg;
#define ATT_GLOAD(tt_)                                                                      \
  do {                                                                                      \
    if ((tt_) < nloc) {                                                                     \
      const int ks_ = (lt0 + (tt_)) * 64;                                                   \
      kreg = *(const bf16x8*)(KBloc + (size_t)(ks_ + lrow) * 64 + lc8);                     \
      vreg = *(const bf16x8*)(VTloc + (size_t)lrow * 1024 + ks_ + lc8);                     \
    } else {                                                                                \
      const int ks_ = ((tt_) - nloc) * 64;                                                  \
      kreg = *(const bf16x8*)(KBctx + (size_t)(ks_ + lrow) * 64 + lc8);                     \
      vreg = *(const bf16x8*)(VTctx + (size_t)lrow * 256 + ks_ + lc8);                      \
    }                                                                                       \
  } while (0)
#define ATT_LSTORE(buf_)                                                                    \
  do {                                                                                      \
    u16* ks__ = (u16*)(smem_raw + (buf_) * ATT_BUF);                                        \
    *(bf16x8*)(ks__ + lrow * KST + lc8) = kreg;                                             \
    *(bf16x8*)(ks__ + 64 * KST + lrow * KST + lc8) = vreg;                                  \
  } while (0)
  ATT_GLOAD(0);
  ATT_LSTORE(0);
  __syncthreads();
  for (int tt = 0; tt < ntile; ++tt) {
    const bool local = tt < nloc;
    const int kstart = local ? (lt0 + tt) * 64 : (tt - nloc) * 64;
    if (tt + 1 < ntile) ATT_GLOAD(tt + 1);
    const u16* Ks = (const u16*)(smem_raw + (tt & 1) * ATT_BUF);
    const u16* Vt = Ks + 64 * KST;
    const bool active = !local || !(kstart > wq_hi + 128 || kstart + 63 < wq_lo - 128);
    if (active) {
      f32x4 st[2][4];
#pragma unroll
      for (int mt = 0; mt < 4; ++mt) {
        f32x4 a0 = {0, 0, 0, 0}, a1 = {0, 0, 0, 0};
#pragma unroll
        for (int ks = 0; ks < 2; ++ks) {
          const bf16x8 kf = *(const bf16x8*)(Ks + (mt * 16 + fr) * KST + ks * 32 + fq * 8);
          a0 = __builtin_amdgcn_mfma_f32_16x16x32_bf16(kf, qf[0][ks], a0, 0, 0, 0);
          a1 = __builtin_amdgcn_mfma_f32_16x16x32_bf16(kf, qf[1][ks], a1, 0, 0, 0);
        }
        st[0][mt] = a0; st[1][mt] = a1;
      }
      bf16x8 pb[2][2];
#pragma unroll
      for (int qt = 0; qt < 2; ++qt) {
        if (local) {
#pragma unroll
          for (int mt = 0; mt < 4; ++mt)
#pragma unroll
            for (int j = 0; j < 4; ++j) {
              int kpos = kstart + mt * 16 + fq * 4 + j;
              int df = qpos[qt] - kpos;
              if (df > 128 || df < -128) st[qt][mt][j] = -1e30f;
            }
        }
        float mx = -1e30f;
#pragma unroll
        for (int mt = 0; mt < 4; ++mt)
#pragma unroll
          for (int j = 0; j < 4; ++j) mx = fmaxf(mx, st[qt][mt][j]);
        mx = fmaxf(mx, __shfl_xor(mx, 16));
        mx = fmaxf(mx, __shfl_xor(mx, 32));
        const float m_new = fmaxf(m_run[qt], mx);
        const float alpha = __expf(m_run[qt] - m_new);
        float rs = 0;
#pragma unroll
        for (int mt = 0; mt < 4; ++mt)
#pragma unroll
          for (int j = 0; j < 4; ++j) {
            float pv = __expf(st[qt][mt][j] - m_new);
            st[qt][mt][j] = pv;
            rs += pv;
          }
        rs += __shfl_xor(rs, 16);
        rs += __shfl_xor(rs, 32);
        l_run[qt] = l_run[qt] * alpha + rs;
        m_run[qt] = m_new;
#pragma unroll
        for (int dt = 0; dt < 4; ++dt) ot[qt][dt] *= alpha;
#pragma unroll
        for (int kk = 0; kk < 2; ++kk) {
          uint2 plo, phi;
          plo.x = cvt_pk_bf16(st[qt][2 * kk][0], st[qt][2 * kk][1]); plo.y = cvt_pk_bf16(st[qt][2 * kk][2], st[qt][2 * kk][3]);
          phi.x = cvt_pk_bf16(st[qt][2 * kk + 1][0], st[qt][2 * kk + 1][1]); phi.y = cvt_pk_bf16(st[qt][2 * kk + 1][2], st[qt][2 * kk + 1][3]);
          pb[qt][kk] = pack8(plo, phi);
        }
      }
#pragma unroll
      for (int kk = 0; kk < 2; ++kk)
#pragma unroll
        for (int dt = 0; dt < 4; ++dt) {
          const u16* vr = Vt + (dt * 16 + fr) * KST + fq * 4;
          const bf16x8 vf = pack8(*(const uint2*)(vr + (2 * kk) * 16), *(const uint2*)(vr + (2 * kk + 1) * 16));
          ot[0][dt] = __builtin_amdgcn_mfma_f32_16x16x32_bf16(vf, pb[0][kk], ot[0][dt], 0, 0, 0);
          ot[1][dt] = __builtin_amdgcn_mfma_f32_16x16x32_bf16(vf, pb[1][kk], ot[1][dt], 0, 0, 0);
        }
    }
    if (tt + 1 < ntile) ATT_LSTORE((tt + 1) & 1);
    __syncthreads();
  }
#undef ATT_GLOAD
#undef ATT_LSTORE
#pragma unroll
  for (int qt = 0; qt < 2; ++qt) {
    const float inv_l = __builtin_amdgcn_rcpf(l_run[qt]);
#pragma unroll
    for (int dt = 0; dt < 4; ++dt) {
      const size_t off = qtok[qt] * 1024 + head * 64 + dt * 16 + fq * 4;
      const size_t offq = qtok[qt] * 2048 + head * 64 + dt * 16 + fq * 4;
      uint2 g = *(const uint2*)(GB + off);
      uint2 o;
      o.x = cvt_pk_bf16(ot[qt][dt][0] * inv_l * bflo(g.x), ot[qt][dt][1] * inv_l * bfhi(g.x));
      o.y = cvt_pk_bf16(ot[qt][dt][2] * inv_l * bflo(g.y), ot[qt][dt][3] * inv_l * bfhi(g.y));
      *(uint2*)(Q + offq) = o;
    }
  }
}

__device__ __forceinline__ void phase_gn(const Params& p) {
  const u16* Y0 = (const u16*)(p.ws + OFF_ZA);
  const u16* Y1 = (const u16*)(p.ws + OFF_ZA + SZ_ACT);
  const u16* VC = (const u16*)(p.ws + OFF_VC);
  const float* BD = (const float*)(p.ws + OFF_BD);
  u16* GA = (u16*)(p.ws + OFF_AQ);
  const int gt = blockIdx.x * NTHR + threadIdx.x, gs = gridDim.x * NTHR;
  const int hi = gt & 127, h = hi >> 3, cbase = h * 64 + (hi & 7) * 8;
  float lw[8], lb[8];
#pragma unroll
  for (int e = 0; e < 8; ++e) { lw[e] = p.ln_w[cbase + e]; lb[e] = p.ln_b[cbase + e]; }
  for (int u = gt; u < NTOK * 128; u += gs) {
    const int tok = u >> 7;
    const size_t off = (size_t)tok * 1024 + cbase;
    bf16x8 a = *(const bf16x8*)(Y0 + off), bq = *(const bf16x8*)(Y1 + off);
    const size_t offg = (size_t)tok * 2048 + cbase;
    bf16x8 vc = *(const bf16x8*)(VC + off), g = *(const bf16x8*)(GA + offg);
    float y[8], s1 = 0, s2 = 0;
#pragma unroll
    for (int e = 0; e < 8; ++e) {
      y[e] = bf2f((u16)a[e]) + bf2f((u16)bq[e]);
      s1 += y[e];
      s2 += y[e] * y[e];
    }
    s1 = red8(s1);
    s2 = red8(s2);
    const float mu = s1 * (1.f / 64.f);
    const float var = fmaxf(s2 * (1.f / 64.f) - mu * mu, 0.f);
    const float rstd = rsqrtf(var + 64e-5f);
    const float bd = BD[tok * 16 + h];
    bf16x8 o;
#pragma unroll
    for (int e = 0; e < 8; ++e) {
      float v = (y[e] - mu) * rstd * lw[e] + lb[e] + bd * bf2f((u16)vc[e]);
      o[e] = (short)f2bf(v * bf2f((u16)g[e]));
    }
    *(bf16x8*)(GA + offg) = o;
  }
}

__device__ __forceinline__ void phase_final(const Params& p) {
  const int lane = threadIdx.x & 63, wv = threadIdx.x >> 6;
  for (int tok = blockIdx.x * 8 + wv; tok < NTOK; tok += gridDim.x * 8) {
    float* xr = p.out + (size_t)tok * 1024;
    float4 v[4];
    float ss = 0;
#pragma unroll
    for (int i = 0; i < 4; ++i) {
      v[i] = *(const float4*)(xr + i * 256 + lane * 4);
      ss += v[i].x * v[i].x + v[i].y * v[i].y + v[i].z * v[i].z + v[i].w * v[i].w;
    }
    ss = wave_sum(ss);
    float rstd = rsqrtf(ss * (1.f / 1024.f) + 1e-6f);
#pragma unroll
    for (int i = 0; i < 4; ++i) {
      float4 nw = *(const float4*)(p.fnw + i * 256 + lane * 4);
      float4 o = make_float4(v[i].x * rstd * nw.x, v[i].y * rstd * nw.y, v[i].z * rstd * nw.z, v[i].w * rstd * nw.w);
      *(float4*)(xr + i * 256 + lane * 4) = o;
    }
  }
}

#define XB_TMO      128
#define XB_XCNT(j)  (256  + 64 * (j))
#define XB_XSUB(j)  (1280 + 64 * (j))
#define XB_XGEN(j)  (2304 + 64 * (j))
#define XB_TOP      3328
#define XB_TOPGEN   3392
#define XCD_BAR_WORDS 3456
#define XB_SPIN_CAP (1u << 18)
__device__ __forceinline__ unsigned xb_xcc_id() { return (unsigned)__builtin_amdgcn_s_getreg((3 << 11) | 20) & 0xFu; }
#define XB_SPIN(cond, bar) do { unsigned _sp = 0; while (cond) { __builtin_amdgcn_s_sleep(1); \
    if ((++_sp & 255u) == 0u) { if (xb_ld(&(bar)[XB_TMO])) break; if (_sp > XB_SPIN_CAP) { atomicAdd(&(bar)[XB_TMO], 1u); break; } } } } while (0)
struct XcdBarrier { unsigned* bar; unsigned x; volatile LAS unsigned* st; };
__device__ __forceinline__ XcdBarrier xcd_barrier_post(unsigned* bar, volatile LAS unsigned* st) {
  XcdBarrier b; b.bar = bar; b.x = xb_xcc_id(); b.st = st;
  if (threadIdx.x == 0) (void)xb_add(&bar[XB_XCNT(b.x)], 1u);
  return b;
}
__device__ __forceinline__ void xcd_barrier_complete(unsigned* bar, unsigned x, unsigned& nloc, unsigned& nx) {
  const unsigned G = gridDim.x * gridDim.y * gridDim.z;
  unsigned sum, cnt, mine, sp = 0u;
  for (;;) {
    sum = 0u; cnt = 0u; mine = 0u;
#pragma unroll
    for (unsigned j = 0; j < 16; ++j) { const unsigned c = xb_ld(&bar[XB_XCNT(j)]); sum += c; cnt += (c > 0u) ? 1u : 0u; mine = (j == x) ? c : mine; }
    if (sum == G) break;
    __builtin_amdgcn_s_sleep(1);
    if ((++sp & 255u) == 0u) { if (xb_ld(&bar[XB_TMO])) break; if (sp > XB_SPIN_CAP) { atomicAdd(&bar[XB_TMO], 1u); break; } }
  }
  nloc = mine > 0u ? mine : 1u; nx = cnt > 0u ? cnt : 1u;
}
__device__ __forceinline__ void xcd_barrier(const XcdBarrier& b) {
  asm volatile("s_waitcnt vmcnt(0)" ::: "memory");
  __syncthreads();
  if (threadIdx.x == 0) {
    unsigned* bar = b.bar;
    __builtin_amdgcn_s_waitcnt(0);
    unsigned nloc = b.st[0], nx = b.st[1];
    if (nloc == 0u) { xcd_barrier_complete(bar, b.x, nloc, nx); b.st[0] = nloc; b.st[1] = nx; }
    const unsigned old = xb_add(&bar[XB_XSUB(b.x)], 1u);
    const unsigned gen = old / nloc;
    if (old + 1u == (gen + 1u) * nloc) {
      __builtin_amdgcn_fence(__ATOMIC_RELEASE, "agent");
      asm volatile("s_waitcnt vmcnt(0)" ::: "memory");
      const unsigned og = xb_add(&bar[XB_TOP], 1u);
      const unsigned tg = og / nx;
      if (og + 1u == (tg + 1u) * nx) xb_add(&bar[XB_TOPGEN], 1u);
      else XB_SPIN(xb_ld(&bar[XB_TOPGEN]) == tg, bar);
      __builtin_amdgcn_fence(__ATOMIC_ACQUIRE, "agent");
      xb_add(&bar[XB_XGEN(b.x)], 1u);
      asm volatile("s_waitcnt vmcnt(0)" ::: "memory");
    } else {
      XB_SPIN(xb_ld(&bar[XB_XGEN(b.x)]) == gen, bar);
      __builtin_amdgcn_fence(__ATOMIC_ACQUIRE, "agent");
      asm volatile("s_waitcnt vmcnt(0)" ::: "memory");
    }
  }
  __syncthreads();
}

__global__ void __launch_bounds__(NTHR) fwd_megakernel(Params p) {
  cg::grid_group grid = cg::this_grid();
  __shared__ int s_item[4];
  if (threadIdx.x == 0) { s_item[0] = 0; s_item[1] = 0; s_item[2] = 0; s_item[3] = 0; }
  __syncthreads();
  XcdBarrier xb = xcd_barrier_post((unsigned*)(p.ws + OFF_BAR), (volatile LAS unsigned*)&s_item[2]);
#ifndef PHM
#define PHM 0xFFFF
#endif
#ifndef DUP
#define DUP 0
#endif
  if (PHM & 1) phase0(p);
  if (DUP & 1) { __syncthreads(); phase0(p); }
  if (gridDim.x > 65535u) grid.sync();
  if (threadIdx.x == 0) {
    unsigned sp = 0;
    while (xb_ld((unsigned*)(p.ws + OFF_MCNT)) < 192u) { __builtin_amdgcn_s_sleep(1); if (++sp > (1u << 22)) break; }
    __builtin_amdgcn_fence(__ATOMIC_ACQUIRE, "agent");
    asm volatile("s_waitcnt vmcnt(0)" ::: "memory");
  }
  __syncthreads();
  if (PHM & 2) phase1(p);
  if (DUP & 2) phase1(p);
  xcd_barrier(xb);
  LAS unsigned char* lds = (LAS unsigned char*)smem_raw;
  if (PHM & 4) {
    Gemm g{(const u16*)(p.ws + OFF_H), (const u16*)(p.ws + OFF_WIN), 1024, 1024, 1024, NTOK, INWP};
    StaticOrder S; S.init(NTOK, INWP, (int)gridDim.x, (int)blockIdx.x);
    EpiIn E{p.ws, p.out};
    gemm_phase<EpiIn>(lds, g, S, E);
    if (DUP & 4) { __syncthreads(); gemm_phase<EpiIn>(lds, g, S, E); }
  }
  xcd_barrier(xb);
  if (PHM & 8) phase_conv(p);
  if (DUP & 8) phase_conv(p);
  xcd_barrier(xb);
  {
    int* qctr = (int*)(p.ws + OFF_QCTR);
    for (;;) {
      __syncthreads();
      if (threadIdx.x == 0) s_item[0] = atomicAdd(qctr, 1);
      __syncthreads();
      const int item = __builtin_amdgcn_readfirstlane(s_item[0]);
      if (item >= 1344) break;
      if (item < 64) { if (PHM & 16) scan_item(p, true, item); }
      else if (item < 576) { if (PHM & 16) scan_item(p, false, item - 64); }
      else if (item < 832) { if (PHM & 32) attn_item(p, true, item - 576); }
      else { if (PHM & 32) attn_item(p, false, item - 832); }
    }
  }
  xcd_barrier(xb);
  if (PHM & 128) {
    Gemm g{(const u16*)(p.ws + OFF_AQ), (const u16*)(p.ws + OFF_WO), 2048, 2048, 2048, NTOK, 1024};
    StaticOrder S; S.init(NTOK, 1024, (int)gridDim.x, (int)blockIdx.x, 64 * EpiMerge::MF);
    EpiMerge E{(const u16*)p.out, (u16*)(p.ws + OFF_ZA + 2 * SZ_ACT)};
    gemm_phase<EpiMerge>(lds, g, S, E);
    if (DUP & 32) { __syncthreads(); gemm_phase<EpiMerge>(lds, g, S, E); }
  }
  xcd_barrier(xb);
  if (PHM & 256) {
    Gemm g{(const u16*)(p.ws + OFF_ZA + 2 * SZ_ACT), (const u16*)(p.ws + OFF_WOUT), 1024, 1024, 1024, NTOK, 1024};
    StaticOrder S; S.init(NTOK, 1024, (int)gridDim.x, (int)blockIdx.x, 64 * EpiOut::MF);
    EpiOut E{p.x_prompt, p.x_sample, (const float*)(p.ws + OFF_MOD), p.fnw, p.out, (float*)(p.ws + OFF_RSUM), (unsigned*)(p.ws + OFF_PCNT)};
    gemm_phase<EpiOut>(lds, g, S, E);
    if (DUP & 64) { __syncthreads(); gemm_phase<EpiOut>(lds, g, S, E); }
  }
}

extern "C" void kernel_launch(void* const* d_in, const int* in_sizes, int n_in, void* d_out, int out_size, void* d_ws,
                              size_t ws_size, hipStream_t stream) {
  constexpr size_t kDynLds = 131072;
  static int grid_blocks = 0;
  if (!grid_blocks) {
    int dev = 0, cus = 0, per_cu = 0;
    hipGetDevice(&dev);
    hipDeviceGetAttribute(&cus, hipDeviceAttributeMultiprocessorCount, dev);
    hipFuncSetAttribute((const void*)fwd_megakernel, hipFuncAttributeMaxDynamicSharedMemorySize, (int)kDynLds);
    hipOccupancyMaxActiveBlocksPerMultiprocessor(&per_cu, (const void*)fwd_megakernel, NTHR, kDynLds);
    if (per_cu < 1) { fprintf(stderr, "occupancy query returned %d\n", per_cu); return; }
    if (cus < 256) { fprintf(stderr, "this kernel needs >= 256 CUs (fused final-norm epilogue: one 192-row unit per workgroup)\n"); return; }
    grid_blocks = cus;
  }
  if (ws_size < WS_NEED) { fprintf(stderr, "workspace too small: %zu < %zu\n", ws_size, WS_NEED); return; }
  Params p{};
  const float** pp = (const float**)&p;
  for (int i = 0; i < 26; ++i) pp[i] = (const float*)d_in[i];
  p.out = (float*)d_out;
  p.ws = (char*)d_ws;
  hipMemsetAsync((char*)d_ws + OFF_QCTR, 0, OFF_WIN - OFF_QCTR, stream);
  void* args[] = {&p};
  hipError_t e = hipLaunchCooperativeKernel((const void*)fwd_megakernel, dim3(grid_blocks), dim3(NTHR), args, kDynLds, stream);
  if (e != hipSuccess) fprintf(stderr, "cooperative launch failed: %s (grid %d)\n", hipGetErrorString(e), grid_blocks);
}
```

```cpp
#include <hip/hip_runtime.h>
#include <hip/hip_bf16.h>
#include <hip/hip_cooperative_groups.h>
#include <cstdio>
namespace cg = cooperative_groups;

typedef unsigned short u16;
using bf16 = __hip_bfloat16;
using bf16x8 = __attribute__((ext_vector_type(8))) short;
using bf16x4 = __attribute__((ext_vector_type(4))) short;
using f32x4 = __attribute__((ext_vector_type(4))) float;
using f32x2 = __attribute__((ext_vector_type(2))) float;

constexpr int DM = 1024;
constexpr int NTOK = 12288;
constexpr int NCTX = 8192;
constexpr int INW = 8832;
constexpr int INWP = 8960;
constexpr int ZAW = 3200;
constexpr int NTHR = 512;

constexpr size_t OFF_MOD = 0;
constexpr size_t OFF_ROPE = 65536;
constexpr size_t OFF_QCTR = 81920;
constexpr size_t OFF_BAR = 98304;
constexpr size_t OFF_MCNT = 82048;
constexpr size_t OFF_PCNT = 114688;
constexpr size_t OFF_RSUM = 131072;
constexpr size_t OFF_WIN = 196608;
constexpr size_t OFF_WO = OFF_WIN + (size_t)INWP * 1024 * 2;
constexpr size_t OFF_WOUT = OFF_WO + (size_t)1024 * 2048 * 2;
constexpr size_t SZ_ACT = (size_t)NTOK * 1024 * 2;
constexpr size_t OFF_H = OFF_WOUT + (size_t)1024 * 1024 * 2;
constexpr size_t OFF_KC = OFF_H + SZ_ACT;
constexpr size_t OFF_VC = OFF_KC + SZ_ACT;
constexpr size_t OFF_ZA = OFF_VC + SZ_ACT;
constexpr size_t OFF_AQ = OFF_ZA + (size_t)NTOK * ZAW * 2;
constexpr size_t OFF_GB = OFF_AQ + 2 * SZ_ACT;
constexpr size_t OFF_KL = OFF_GB + SZ_ACT;
constexpr size_t OFF_VL = OFF_KL + (size_t)4096 * 256 * 2;
constexpr size_t OFF_WA = OFF_WIN;
constexpr size_t OFF_RN = OFF_WA + (size_t)NTOK * 128 * 2;
constexpr size_t OFF_BD = OFF_RN + (size_t)NTOK * 16 * 4;
constexpr size_t OFF_KBC = OFF_BD + (size_t)NTOK * 16 * 4;
constexpr size_t OFF_VTC = OFF_KBC + (size_t)128 * 256 * 64 * 2;
constexpr size_t OFF_KBL = OFF_VTC + (size_t)128 * 256 * 64 * 2;
constexpr size_t OFF_VTL = OFF_KBL + (size_t)16 * 1024 * 64 * 2;
constexpr size_t OFF_KBK = OFF_VTL + (size_t)16 * 1024 * 64 * 2;
constexpr size_t OFF_VTK = OFF_KBK + (size_t)16 * 256 * 64 * 2;
static_assert(OFF_VTK + (size_t)16 * 256 * 64 * 2 <= OFF_WO, "WIN region overflow");
constexpr size_t WS_NEED = OFF_VL + (size_t)4096 * 256 * 2;

constexpr size_t OUT_NEWK = (size_t)NTOK * 1024;
constexpr size_t OUT_NEWV = OUT_NEWK + (size_t)32 * 4 * 256 * 64;
constexpr size_t OUT_STATE = OUT_NEWV + (size_t)32 * 4 * 256 * 64;

struct Params {
  const float *x_prompt, *x_sample, *cache_k, *cache_v, *state, *c, *c_ctx, *norm_w, *w_ada, *b_ada, *w_in, *conv_a,
      *w0, *w_up, *a0, *a_up, *k_k, *k_a, *r_k, *ln_w, *ln_b, *w_oA, *sink, *w_oB, *w_out, *fnw;
  float* out;
  char* ws;
};

extern __shared__ __attribute__((aligned(16))) char smem_raw[];

__device__ __forceinline__ u16 f2bf(float f) {
  unsigned u = __float_as_uint(f);
  u += 0x7fffu + ((u >> 16) & 1u);
  return (u16)(u >> 16);
}
__device__ __forceinline__ float bf2f(u16 h) { return __uint_as_float(((unsigned)h) << 16); }
__device__ __forceinline__ float sigmoidf_(float x) { return __builtin_amdgcn_rcpf(1.f + __expf(-x)); }
__device__ __forceinline__ float siluf_(float x) { return x * __builtin_amdgcn_rcpf(1.f + __expf(-x)); }

__device__ __forceinline__ unsigned xb_ld(unsigned* p)              { return __hip_atomic_load(p, __ATOMIC_RELAXED, __HIP_MEMORY_SCOPE_AGENT); }
__device__ __forceinline__ unsigned xb_add(unsigned* p, unsigned v) { return __hip_atomic_fetch_add(p, v, __ATOMIC_RELAXED, __HIP_MEMORY_SCOPE_AGENT); }

typedef unsigned u32x4 __attribute__((ext_vector_type(4)));
typedef __bf16 bf16v2_t __attribute__((ext_vector_type(2)));
__device__ __forceinline__ unsigned cvt_pk_bf16(float lo, float hi) {
  f32x2 f = {lo, hi};
  bf16v2_t b = __builtin_convertvector(f, bf16v2_t);
  return __builtin_bit_cast(unsigned, b);
}

template <int CTRL>
__device__ __forceinline__ float dppf(float v) {
  return __builtin_bit_cast(float, __builtin_amdgcn_update_dpp(0, __builtin_bit_cast(int, v), CTRL, 0xf, 0xf, true));
}
__device__ __forceinline__ float red8(float v) {
  v += dppf<0xB1>(v);
  v += dppf<0x4E>(v);
  v += dppf<0x141>(v);
  return v;
}
__device__ __forceinline__ float red16(float v) {
  v = red8(v);
  v += dppf<0x140>(v);
  return v;
}
__device__ __forceinline__ float wave_sum(float v) {
  for (int o = 32; o > 0; o >>= 1) v += __shfl_xor(v, o);
  return v;
}

__device__ __forceinline__ void transpose_tile(const float* src, int lds, u16* dst, int ldd, int k0, int n0, bool zero) {
  const int tid = threadIdx.x;
  float* sm = (float*)smem_raw;
  {
    int r = tid >> 4, c4 = (tid & 15) * 4;
#pragma unroll
    for (int pass = 0; pass < 2; ++pass) {
      int rr = r + pass * 32;
      float4 v = make_float4(0, 0, 0, 0);
      if (!zero) v = *(const float4*)(src + (size_t)(k0 + rr) * lds + n0 + c4);
      sm[rr * 65 + c4 + 0] = v.x; sm[rr * 65 + c4 + 1] = v.y; sm[rr * 65 + c4 + 2] = v.z; sm[rr * 65 + c4 + 3] = v.w;
    }
  }
  __syncthreads();
  {
    int n = tid >> 3, k8 = (tid & 7) * 8;
    bf16x8 o;
#pragma unroll
    for (int e = 0; e < 8; ++e) o[e] = (short)f2bf(sm[(k8 + e) * 65 + n]);
    *(bf16x8*)(dst + (size_t)(n0 + n) * ldd + k0 + k8) = o;
  }
  __syncthreads();
}

__device__ __forceinline__ void phase0(const Params& p) {
  const int tid = threadIdx.x;
  float* mod = (float*)(p.ws + OFF_MOD);
  if (blockIdx.x == 1) {
    float* rt = (float*)(p.ws + OFF_ROPE);
    for (int idx = tid; idx < 1024; idx += NTHR) {
      int pos = idx >> 4, i = idx & 15;
      float inv = exp2f(-(float)i * (13.287712379549449f / 16.f));
      float ang = (float)pos * inv;
      rt[idx] = __cosf(ang);
      rt[1024 + idx] = __sinf(ang);
    }
  }
  float* sm = (float*)smem_raw;
  const int NMOD = 192, NTR_IN = 16 * 70, NTR = NTR_IN + 3 * 256;
  for (int item = blockIdx.x; item < NMOD + NTR; item += gridDim.x) {
    if (item < NMOD) {
      int col0 = item * 16, kg = tid >> 4, j = tid & 15;
      float* sc = sm + 4096;
#pragma unroll
      for (int q = 0; q < 10; ++q) {
        const int e = tid + q * NTHR, c = e >> 10, kx = e & 1023;
        const float cv = (c < 4) ? p.c[c * 1024 + kx] : p.c_ctx[kx];
        sc[e] = siluf_(cv);
      }
      float wv[32];
#pragma unroll
      for (int q = 0; q < 32; ++q) wv[q] = p.w_ada[(size_t)(kg * 32 + q) * 3072 + col0 + j];
      __syncthreads();
      float acc[5] = {0, 0, 0, 0, 0};
#pragma unroll
      for (int q = 0; q < 32; ++q) {
#pragma unroll
        for (int c = 0; c < 5; ++c) acc[c] += sc[c * 1024 + kg * 32 + q] * wv[q];
      }
#pragma unroll
      for (int c = 0; c < 5; ++c) sm[(kg * 5 + c) * 16 + j] = acc[c];
      __syncthreads();
      if (tid < 80) {
        int c = tid >> 4;
        float s = 0;
        for (int g = 0; g < 32; ++g) s += sm[(g * 5 + c) * 16 + j];
        mod[c * 3072 + col0 + j] = s + p.b_ada[col0 + j];
      }
      asm volatile("s_waitcnt vmcnt(0)" ::: "memory");
      __syncthreads();
      if (tid == 0) {
        __builtin_amdgcn_fence(__ATOMIC_RELEASE, "agent");
        asm volatile("s_waitcnt vmcnt(0)" ::: "memory");
        xb_add((unsigned*)(p.ws + OFF_MCNT), 1u);
      }
    } else {
      int t = item - NMOD;
      if (t < NTR_IN) {
        const int nt2 = t % 70, kt = t / 70;
        const int k0 = kt * 64, n0 = nt2 * 128;
        const int r = tid >> 4, c4 = (tid & 15) * 4;
        float4 v[2][2];
#pragma unroll
        for (int sub = 0; sub < 2; ++sub)
#pragma unroll
          for (int pass = 0; pass < 2; ++pass) {
            const int nn = n0 + sub * 64;
            v[sub][pass] = (nn < INW) ? *(const float4*)(p.w_in + (size_t)(k0 + r + pass * 32) * INW + nn + c4) : make_float4(0, 0, 0, 0);
          }
#pragma unroll
        for (int sub = 0; sub < 2; ++sub)
#pragma unroll
          for (int pass = 0; pass < 2; ++pass) {
            float* b_ = sm + sub * (64 * 65) + (r + pass * 32) * 65 + c4;
            b_[0] = v[sub][pass].x; b_[1] = v[sub][pass].y; b_[2] = v[sub][pass].z; b_[3] = v[sub][pass].w;
          }
        __syncthreads();
        {
          const int n = tid >> 3, k8 = (tid & 7) * 8;
          u16* dstp = (u16*)(p.ws + OFF_WIN);
#pragma unroll
          for (int sub = 0; sub < 2; ++sub) {
            const float* b_ = sm + sub * (64 * 65);
            u32x4 o;
            o.x = cvt_pk_bf16(b_[(k8 + 0) * 65 + n], b_[(k8 + 1) * 65 + n]); o.y = cvt_pk_bf16(b_[(k8 + 2) * 65 + n], b_[(k8 + 3) * 65 + n]);
            o.z = cvt_pk_bf16(b_[(k8 + 4) * 65 + n], b_[(k8 + 5) * 65 + n]); o.w = cvt_pk_bf16(b_[(k8 + 6) * 65 + n], b_[(k8 + 7) * 65 + n]);
            *(u32x4*)(dstp + (size_t)(n0 + sub * 64 + n) * 1024 + k0 + k8) = o;
          }
        }
        __syncthreads();
      } else {
        int u = t - NTR_IN, w = u >> 8, r = u & 255;
        int nt = r & 15, kt = r >> 4;
        if (w == 0) transpose_tile(p.w_oA, 1024, (u16*)(p.ws + OFF_WO), 2048, kt * 64, nt * 64, false);
        else if (w == 1) transpose_tile(p.w_oB, 1024, (u16*)(p.ws + OFF_WO) + 1024, 2048, kt * 64, nt * 64, false);
        else transpose_tile(p.w_out, 1024, (u16*)(p.ws + OFF_WOUT), 1024, kt * 64, nt * 64, false);
      }
    }
  }
}

__device__ __forceinline__ void phase1(const Params& p) {
  const int lane = threadIdx.x & 63, wv = threadIdx.x >> 6;
  const float* mod = (const float*)(p.ws + OFF_MOD);
  u16* H = (u16*)(p.ws + OFF_H);
  for (int tok = blockIdx.x * 8 + wv; tok < NTOK; tok += gridDim.x * 8) {
    const float* xr = (tok < NCTX) ? p.x_prompt + (size_t)tok * 1024 : p.x_sample + (size_t)(tok - NCTX) * 1024;
    int ci = (tok < NCTX) ? 4 : ((tok - NCTX) >> 10);
    float4 v[4];
    float ss = 0;
#pragma unroll
    for (int i = 0; i < 4; ++i) {
      v[i] = *(const float4*)(xr + i * 256 + lane * 4);
      ss += v[i].x * v[i].x + v[i].y * v[i].y + v[i].z * v[i].z + v[i].w * v[i].w;
    }
    ss = wave_sum(ss);
    float rstd = rsqrtf(ss * (1.f / 1024.f) + 1e-6f);
#pragma unroll
    for (int i = 0; i < 4; ++i) {
      int e = i * 256 + lane * 4;
      float4 nw = *(const float4*)(p.norm_w + e);
      float4 sh = *(const float4*)(mod + ci * 3072 + e);
      float4 sc = *(const float4*)(mod + ci * 3072 + 1024 + e);
      u16 o0 = f2bf(v[i].x * rstd * nw.x * (1.f + sc.x) + sh.x);
      u16 o1 = f2bf(v[i].y * rstd * nw.y * (1.f + sc.y) + sh.y);
      u16 o2 = f2bf(v[i].z * rstd * nw.z * (1.f + sc.z) + sh.z);
      u16 o3 = f2bf(v[i].w * rstd * nw.w * (1.f + sc.w) + sh.w);
      uint2 o;
      o.x = (unsigned)o0 | ((unsigned)o1 << 16);
      o.y = (unsigned)o2 | ((unsigned)o3 << 16);
      *(uint2*)(H + (size_t)tok * 1024 + e) = o;
    }
  }
}


#define LAS __attribute__((address_space(3)))
constexpr int BM = 256, BK = 64, HALF = 128, HTB = HALF * BK * 2, NXCD = 8, WGM = 8;
__device__ __forceinline__ int lds_byte(int r, int c) { const int st = (r >> 4) * 2 + (c >> 5), rr = r & 15, cc = c & 31, ob = rr * 64 + cc * 2; return st * 1024 + (ob ^ (((ob >> 9) & 1) << 5)); }
__device__ __forceinline__ void stage_rc(int b, int& R, int& C) { const int st = b / 1024, sb = b % 1024, swz = sb ^ (((sb >> 9) & 1) << 5); R = (st >> 1) * 16 + swz / 64; C = (st & 1) * 32 + (swz % 64) / 2; }
__device__ __forceinline__ int perm32(int rho) { const int n = rho >> 4, i = rho & 15; return 8 * (i >> 2) + 4 * n + (i & 3); }
struct Unit { int pm, pn; };
struct Gemm { const u16* A; const u16* Bt; int lda, ldb, K, M, N; };
struct StaticOrder {
  int nM, nN, nwg, G, c;
  __device__ void init(int M, int N, int G_, int c_, int rows_per_unit = BM) { nM = M / rows_per_unit; nN = N / BM; nwg = nM * nN; G = G_; c = c_; }
  __device__ bool next(int i, Unit& u) const {
    const long L = (long)i * G + c; if (L >= nwg) return false;
    int wgid = (int)L; { const int q = nwg / NXCD, r = nwg % NXCD, xcd = wgid % NXCD, off = wgid / NXCD; wgid = (xcd < r ? xcd * (q + 1) : r * (q + 1) + (xcd - r) * q) + off; }
    const int nig = WGM * nN, gid = wgid / nig, fm = gid * WGM, gsz = (nM - fm) < WGM ? (nM - fm) : WGM;
    u.pm = fm + ((wgid % nig) % gsz); u.pn = (wgid % nig) / gsz; return true;
  }
};
__device__ __forceinline__ float bflo(unsigned u) { return __uint_as_float(u << 16); }
__device__ __forceinline__ float bfhi(unsigned u) { return __uint_as_float(u & 0xffff0000u); }

struct EpiIn {
  static constexpr bool PERM = true, MID = false, AFTER_DRAIN = false;
  static constexpr int MF = 4;
  static constexpr int MIDT = 0;
  char* ws; float* out;
  __device__ __forceinline__ void mid(f32x4 (&acc)[2][2][4][2], const Unit& u, int wr, int wc, int fr, int fq) const {}
  __device__ __forceinline__ void operator()(const f32x4 (&acc)[2][2][4][2], const Unit& u, int wr, int wc, int fr, int fq) const {
    const int row0 = u.pm * BM + wr * 64 + fr;
#pragma unroll
    for (int bj = 0; bj < 2; ++bj) {
      const int cb = u.pn * BM + bj * HALF;
      const int col0 = cb + wc * 32 + 8 * fq;
      if (cb >= INW) continue;
#pragma unroll
      for (int ai = 0; ai < 2; ++ai)
#pragma unroll
        for (int m = 0; m < 4; ++m) {
          const int row = row0 + ai * HALF + m * 16;
          f32x4 v0 = acc[ai][bj][m][0], v1 = acc[ai][bj][m][1];
          if (cb >= 5248 && cb < 5760 && row < NCTX) {
            const bool isv = cb >= 5504;
            const int c = col0 - (isv ? 5504 : 5248);
            const int b = row >> 8, t = row & 255, hk = c >> 6, d = c & 63;
            float* o = out + (isv ? OUT_NEWV : OUT_NEWK) + ((size_t)(b * 4 + hk) * 256 + t) * 64 + d;
            *(f32x4*)o = v0;
            *(f32x4*)(o + 4) = v1;
            continue;
          }
          u16* dst;
          if (cb < 3200) dst = (u16*)(ws + OFF_ZA) + (size_t)row * ZAW + col0;
          else if (cb < 4224) {
            dst = (u16*)(ws + OFF_AQ) + (size_t)row * 2048 + (col0 - 3200);
#pragma unroll
            for (int j = 0; j < 4; ++j) { v0[j] = siluf_(v0[j]); v1[j] = siluf_(v1[j]); }
          } else if (cb < 5248) {
            dst = (u16*)(ws + OFF_AQ) + (size_t)row * 2048 + 1024 + (col0 - 4224);
            v0 *= 0.125f; v1 *= 0.125f;
          } else if (cb < 5504) dst = (u16*)(ws + OFF_KL) + (size_t)(row - NCTX) * 256 + (col0 - 5248);
          else if (cb < 5760) dst = (u16*)(ws + OFF_VL) + (size_t)(row - NCTX) * 256 + (col0 - 5504);
          else if (cb < 6784) {
            dst = (u16*)(ws + OFF_GB) + (size_t)row * 1024 + (col0 - 5760);
#pragma unroll
            for (int j = 0; j < 4; ++j) { v0[j] = siluf_(v0[j]); v1[j] = siluf_(v1[j]); }
          } else {
            dst = (u16*)out + (size_t)row * 2048 + (col0 - 6784);
#pragma unroll
            for (int j = 0; j < 4; ++j) { v0[j] = sigmoidf_(v0[j]); v1[j] = sigmoidf_(v1[j]); }
          }
          u32x4 w; w.x = cvt_pk_bf16(v0[0], v0[1]); w.y = cvt_pk_bf16(v0[2], v0[3]); w.z = cvt_pk_bf16(v1[0], v1[1]); w.w = cvt_pk_bf16(v1[2], v1[3]);
          *(u32x4*)dst = w;
        }
    }
  }
};
struct EpiMerge {
  static constexpr bool PERM = true, MID = true, AFTER_DRAIN = false;
  static constexpr int MIDT = 16;
  static constexpr int MF = 3;
  const u16* mamb; u16* merged;
  __device__ __forceinline__ void mid(f32x4 (&acc)[2][2][4][2], const Unit& u, int wr, int wc, int fr, int fq) const {
    int lz; asm volatile("v_mov_b32 %0, 0" : "=v"(lz));
    const int row0 = u.pm * (64 * MF) + wr * (16 * MF) + fr + lz, col0 = u.pn * BM + wc * 32 + 8 * fq;
#pragma unroll
    for (int ai = 0; ai < 2; ++ai)
#pragma unroll
      for (int m = 0; m < MF; ++m)
#pragma unroll
        for (int bj = 0; bj < 2; ++bj) {
          const u16* rp = mamb + (size_t)(row0 + ai * (32 * MF) + m * 16) * 2048 + col0 + bj * HALF;
          const u32x4 a = *(const u32x4*)rp, b = *(const u32x4*)(rp + 1024);
          f32x4 r0, r1;
#define RCPF(x) __builtin_amdgcn_rcpf(x)
          r0[0] = bflo(a.x) * RCPF(bflo(b.x)); r0[1] = bfhi(a.x) * RCPF(bfhi(b.x)); r0[2] = bflo(a.y) * RCPF(bflo(b.y)); r0[3] = bfhi(a.y) * RCPF(bfhi(b.y));
          r1[0] = bflo(a.z) * RCPF(bflo(b.z)); r1[1] = bfhi(a.z) * RCPF(bfhi(b.z)); r1[2] = bflo(a.w) * RCPF(bflo(b.w)); r1[3] = bfhi(a.w) * RCPF(bfhi(b.w));
          acc[ai][bj][m][0] *= r0;
          acc[ai][bj][m][1] *= r1;
          __builtin_amdgcn_sched_barrier(0);
        }
  }
  __device__ __forceinline__ void operator()(const f32x4 (&acc)[2][2][4][2], const Unit& u, int wr, int wc, int fr, int fq) const {
    const int row0 = u.pm * (64 * MF) + wr * (16 * MF) + fr, col0 = u.pn * BM + wc * 32 + 8 * fq;
#pragma unroll
    for (int ai = 0; ai < 2; ++ai)
#pragma unroll
      for (int m = 0; m < MF; ++m)
#pragma unroll
        for (int bj = 0; bj < 2; ++bj) {
          const size_t row = (size_t)(row0 + ai * (32 * MF) + m * 16);
          const u32x4 b = *(const u32x4*)(mamb + row * 2048 + 1024 + col0 + bj * HALF);
          const f32x4 v0 = acc[ai][bj][m][0], v1 = acc[ai][bj][m][1];
          u32x4 w;
          w.x = cvt_pk_bf16(v0[0] * bflo(b.x), v0[1] * bfhi(b.x)); w.y = cvt_pk_bf16(v0[2] * bflo(b.y), v0[3] * bfhi(b.y));
          w.z = cvt_pk_bf16(v1[0] * bflo(b.z), v1[1] * bfhi(b.z)); w.w = cvt_pk_bf16(v1[2] * bflo(b.w), v1[3] * bfhi(b.w));
          *(u32x4*)(merged + row * 1024 + col0 + bj * HALF) = w;
          __builtin_amdgcn_sched_barrier(0);
        }
  }
};
struct EpiOut {
  static constexpr bool PERM = false, MID = false, AFTER_DRAIN = true;
  static constexpr int MIDT = 0;
  static constexpr int MF = 3;
  const float *xp, *xs, *mod, *fnw; float* out; float* rsum; unsigned* pcnt;
  __device__ __forceinline__ void mid(f32x4 (&acc)[2][2][4][2], const Unit& u, int wr, int wc, int fr, int fq) const {}
  __device__ __forceinline__ void operator()(f32x4 (&acc)[2][2][4][2], const Unit& u, int wr, int wc, int fr, int fq) const {
    const int row0 = u.pm * (64 * MF) + wr * (16 * MF) + fr, col0 = u.pn * BM + wc * 32 + 4 * fq;
    {
#pragma unroll
      for (int ai = 0; ai < 2; ++ai)
#pragma unroll
        for (int m = 0; m < MF; ++m) {
          const int row = row0 + ai * (32 * MF) + m * 16;
          const float* xr = (row < NCTX) ? xp + (size_t)row * 1024 : xs + (size_t)(row - NCTX) * 1024;
          const float* gr = mod + ((row < NCTX) ? 4 : ((row - NCTX) >> 10)) * 3072 + 2048;
          float ss = 0.f;
#pragma unroll
          for (int bj = 0; bj < 2; ++bj)
#pragma unroll
            for (int n = 0; n < 2; ++n) {
              const f32x4 v = *(const f32x4*)(xr + col0 + bj * HALF + n * 16) + *(const f32x4*)(gr + col0 + bj * HALF + n * 16) * acc[ai][bj][m][n];
              acc[ai][bj][m][n] = v;
              ss += v[0] * v[0] + v[1] * v[1] + v[2] * v[2] + v[3] * v[3];
            }
          ss += __shfl_xor(ss, 16);
          ss += __shfl_xor(ss, 32);
          if (fq == 0) atomicAdd(rsum + row, ss);
        }
    }
    __syncthreads();
    if (threadIdx.x == 0) {
      __builtin_amdgcn_fence(__ATOMIC_RELEASE, "agent");
      asm volatile("s_waitcnt vmcnt(0)" ::: "memory");
      xb_add(pcnt + u.pm, 1u);
      unsigned sp = 0;
      while (xb_ld(pcnt + u.pm) < 4u) { __builtin_amdgcn_s_sleep(1); if (++sp > (1u << 22)) break; }
      __builtin_amdgcn_fence(__ATOMIC_ACQUIRE, "agent");
      asm volatile("s_waitcnt vmcnt(0)" ::: "memory");
    }
    __syncthreads();
    f32x4 w[2][2];
#pragma unroll
    for (int bj = 0; bj < 2; ++bj)
#pragma unroll
      for (int n = 0; n < 2; ++n) w[bj][n] = *(const f32x4*)(fnw + col0 + bj * HALF + n * 16);
#pragma unroll
    for (int ai = 0; ai < 2; ++ai)
#pragma unroll
      for (int m = 0; m < MF; ++m) {
        const int row = row0 + ai * (32 * MF) + m * 16;
        const float tot = __hip_atomic_load(rsum + row, __ATOMIC_RELAXED, __HIP_MEMORY_SCOPE_AGENT);
        const float rstd = rsqrtf(tot * (1.f / 1024.f) + 1e-6f);
        float* orow = out + (size_t)row * 1024;
#pragma unroll
        for (int bj = 0; bj < 2; ++bj)
#pragma unroll
          for (int n = 0; n < 2; ++n) *(f32x4*)(orow + col0 + bj * HALF + n * 16) = acc[ai][bj][m][n] * rstd * w[bj][n];
      }
  }
};

template <class Epi>
__device__ __forceinline__ void gemm_phase(LAS unsigned char* lds, const Gemm g, const StaticOrder& S, const Epi& E) {
  int tid = threadIdx.x;
  asm volatile("" : "+v"(tid));
  const int wid = __builtin_amdgcn_readfirstlane(tid >> 6), lane = tid & 63, wr = wid >> 2, wc = wid & 3, fr = lane & 15, fq = lane >> 4;
  const int nt = g.K / BK;
  unsigned voffA[2], voffB[2];
#pragma unroll
  for (int i = 0; i < 2; ++i) { int R, C; stage_rc(tid * 16 + i * 8192, R, C); const int Rb = Epi::PERM ? ((R & ~31) + perm32(R & 31)) : R;
    voffA[i] = (unsigned)(R * g.lda + C) * 2u; voffB[i] = (unsigned)(Rb * g.ldb + C) * 2u; }
  const size_t kstep = (size_t)(BK * 2);
  constexpr int MF = Epi::MF;
  const size_t hstepA = (size_t)(32 * MF) * g.lda * 2, hstepB = (size_t)HALF * g.ldb * 2;
  const size_t tstepA = 2 * hstepA, tstepB = 2 * hstepB;
  const unsigned ldsw = (unsigned)wid * 1024u;
  const int aoff = lds_byte(wr * (16 * MF) + fr, fq * 8), boff = lds_byte(wc * 32 + fr, fq * 8);
#define PG8_SA(b, h) (((b) * 2 + (h)) * HTB)
#define PG8_SB(b, h) ((4 + (b) * 2 + (h)) * HTB)
#define PG8_STAGE(bufoff, gbase, voff) do { _Pragma("unroll") for (int _i = 0; _i < 2; ++_i) \
    __builtin_amdgcn_global_load_lds((const unsigned*)((const char*)(gbase) + (voff)[_i]), (LAS unsigned*)(lds + (bufoff) + ldsw + _i * 8192), 16, 0, 0); } while (0)
#define PG8_LDA(dst, b, h) do { _Pragma("unroll") for (int m = 0; m < MF; ++m) _Pragma("unroll") for (int k = 0; k < 2; ++k) dst[m][k] = *(const LAS bf16x8*)(lds + PG8_SA(b, h) + aoff + m * 2048 + k * 1024); } while (0)
#define PG8_LDB(dst, b, h) do { _Pragma("unroll") for (int n = 0; n < 2; ++n) _Pragma("unroll") for (int k = 0; k < 2; ++k) dst[n][k] = *(const LAS bf16x8*)(lds + PG8_SB(b, h) + boff + n * 2048 + k * 1024); } while (0)
#define PG8_MMA(ai, bj, At, Bt) do { __builtin_amdgcn_s_setprio(1); _Pragma("unroll") for (int m = 0; m < MF; ++m) _Pragma("unroll") for (int n = 0; n < 2; ++n) _Pragma("unroll") for (int k = 0; k < 2; ++k) \
    acc[ai][bj][m][n] = __builtin_amdgcn_mfma_f32_16x16x32_bf16(Bt[n][k], At[m][k], acc[ai][bj][m][n], 0, 0, 0); __builtin_amdgcn_s_setprio(0); } while (0)
#define PG8_WAIT_V(n) asm volatile("s_waitcnt vmcnt(" #n ")" ::: "memory")
#define PG8_WAIT_L(n) asm volatile("s_waitcnt lgkmcnt(" #n ")" ::: "memory")
#define PG8_WAIT_LB do { if constexpr (MF == 4) PG8_WAIT_L(8); else PG8_WAIT_L(6); } while (0)
#define PG8_BAR __builtin_amdgcn_s_barrier()
#define PG8_SCHED __builtin_amdgcn_sched_barrier(0)
  Unit cur, nxt; int ui = 0;
  if (!S.next(0, cur)) return;
  f32x4 acc[2][2][4][2];
#pragma unroll
  for (int a = 0; a < 2; ++a)
#pragma unroll
    for (int b = 0; b < 2; ++b)
#pragma unroll
      for (int m = 0; m < 4; ++m)
#pragma unroll
        for (int n = 0; n < 2; ++n) acc[a][b][m][n] = (f32x4){0.f, 0.f, 0.f, 0.f};
  bf16x8 At[4][2], B0[2][2], B1[2][2];
  const char* cA = (const char*)g.A + (size_t)cur.pm * tstepA; const char* cB = (const char*)g.Bt + (size_t)cur.pn * tstepB;
  PG8_STAGE(PG8_SB(0, 0), cB, voffB); PG8_STAGE(PG8_SA(0, 0), cA, voffA); PG8_STAGE(PG8_SB(0, 1), cB + hstepB, voffB); PG8_STAGE(PG8_SA(0, 1), cA + hstepA, voffA);
  if (wr == 1) PG8_BAR;
  PG8_WAIT_V(4); PG8_BAR;
  PG8_STAGE(PG8_SB(1, 0), cB + kstep, voffB); PG8_STAGE(PG8_SA(1, 0), cA + kstep, voffA); PG8_STAGE(PG8_SB(1, 1), cB + hstepB + kstep, voffB);
  PG8_WAIT_V(6); PG8_BAR;
  for (;;) {
    const bool has_next = S.next(ui + 1, nxt);
    const char* nA = has_next ? (const char*)g.A + (size_t)nxt.pm * tstepA : cA; const char* nB = has_next ? (const char*)g.Bt + (size_t)nxt.pn * tstepB : cB;
    for (int t = 0; t < nt; t += 2) {
      const bool last = (t == nt - 2);
      const char* a1 = cA + (size_t)(t + 1) * kstep;
      const char* a2 = last ? nA : cA + (size_t)(t + 2) * kstep; const char* b2 = last ? nB : cB + (size_t)(t + 2) * kstep;
      const char* a3 = a2 + kstep; const char* b3 = b2 + kstep;
      if constexpr (Epi::MID) { if (t == Epi::MIDT) E.mid(acc, cur, wr, wc, fr, fq); }
      PG8_LDB(B0, 0, 0); PG8_SCHED; PG8_LDA(At, 0, 0); PG8_STAGE(PG8_SA(1, 1), a1 + hstepA, voffA);
      PG8_WAIT_LB; PG8_BAR; PG8_WAIT_L(0); PG8_MMA(0, 0, At, B0); PG8_BAR; PG8_SCHED;
      PG8_LDB(B1, 0, 1); PG8_STAGE(PG8_SB(0, 0), b2, voffB);
      PG8_BAR; PG8_WAIT_L(0); PG8_MMA(0, 1, At, B1); PG8_BAR;
      PG8_LDA(At, 0, 1); PG8_STAGE(PG8_SA(0, 0), a2, voffA);
      PG8_BAR; PG8_WAIT_L(0); PG8_MMA(1, 0, At, B0); PG8_BAR; PG8_SCHED;
      PG8_STAGE(PG8_SB(0, 1), b2 + hstepB, voffB);
      PG8_WAIT_V(6); PG8_BAR; PG8_MMA(1, 1, At, B1); PG8_BAR;
      PG8_LDB(B0, 1, 0); PG8_SCHED; PG8_LDA(At, 1, 0); PG8_STAGE(PG8_SA(0, 1), a2 + hstepA, voffA);
      PG8_WAIT_LB; PG8_BAR; PG8_WAIT_L(0); PG8_MMA(0, 0, At, B0); PG8_BAR; PG8_SCHED;
      PG8_LDB(B1, 1, 1); PG8_STAGE(PG8_SB(1, 0), b3, voffB);
      PG8_BAR; PG8_WAIT_L(0); PG8_MMA(0, 1, At, B1); PG8_BAR;
      PG8_LDA(At, 1, 1); PG8_STAGE(PG8_SA(1, 0), a3, voffA);
      PG8_BAR; PG8_WAIT_L(0); PG8_MMA(1, 0, At, B0); PG8_BAR; PG8_SCHED;
      PG8_STAGE(PG8_SB(1, 1), b3 + hstepB, voffB);
      PG8_WAIT_V(6); PG8_BAR; PG8_MMA(1, 1, At, B1); PG8_BAR;
    }
    if constexpr (!Epi::AFTER_DRAIN) E(acc, cur, wr, wc, fr, fq);
    if (!has_next) break;
#pragma unroll
    for (int a = 0; a < 2; ++a)
#pragma unroll
      for (int b = 0; b < 2; ++b)
#pragma unroll
        for (int m = 0; m < 4; ++m)
#pragma unroll
          for (int n = 0; n < 2; ++n) acc[a][b][m][n] = (f32x4){0.f, 0.f, 0.f, 0.f};
    cur = nxt; cA = nA; cB = nB; ++ui;
  }
  PG8_WAIT_V(0);
  if (wr == 0) PG8_BAR;
  PG8_BAR;
  if constexpr (Epi::AFTER_DRAIN) E(acc, cur, wr, wc, fr, fq);
#undef PG8_SA
#undef PG8_SB
#undef PG8_STAGE
#undef PG8_LDA
#undef PG8_LDB
#undef PG8_MMA
#undef PG8_WAIT_V
#undef PG8_WAIT_L
#undef PG8_WAIT_LB
#undef PG8_BAR
#undef PG8_SCHED
}

__device__ __forceinline__ void phase_conv(const Params& p) {
  const u16* ZA = (const u16*)(p.ws + OFF_ZA);
  u16* RC = (u16*)(p.ws + OFF_H);
  u16* KC = (u16*)(p.ws + OFF_KC);
  u16* VC = (u16*)(p.ws + OFF_VC);
  u16* WA = (u16*)(p.ws + OFF_WA);
  float* RN = (float*)(p.ws + OFF_RN);
  float* BD = (float*)(p.ws + OFF_BD);
  const int gt = blockIdx.x * NTHR + threadIdx.x, gs = gridDim.x * NTHR;
  {
    const int hi = gt & 127, h = hi >> 3, i = hi & 7;
    const int cbase = h * 64 + i * 8;
    float kkw[8], rkw[8];
#pragma unroll
    for (int e = 0; e < 8; ++e) { kkw[e] = p.k_k[cbase + e]; rkw[e] = p.r_k[cbase + e]; }
    float cw3[3][3][8];
#pragma unroll
    for (int sa = 0; sa < 3; ++sa)
#pragma unroll
      for (int tp = 0; tp < 3; ++tp)
#pragma unroll
        for (int e = 0; e < 8; ++e) cw3[sa][tp][e] = p.conv_a[tp * ZAW + sa * 1024 + cbase + e];
    for (int u = gt; u < (NTOK / 4) * 128; u += gs) {
      const int tok0 = (u >> 7) * 4;
      int t0, T;
      if (tok0 < NCTX) { t0 = tok0 & 255; T = 256; } else { t0 = (tok0 - NCTX) & 1023; T = 1024; }
      float res[3][4][8];
#pragma unroll
      for (int sa = 0; sa < 3; ++sa) {
        const int col = sa * 1024 + cbase;
        const bf16x8 z = {0, 0, 0, 0, 0, 0, 0, 0};
        bf16x8 rw[6];
#pragma unroll
        for (int q = 0; q < 6; ++q) {
          const bool ok = (q == 0) ? (t0 > 0) : ((q == 5) ? (t0 + 4 < T) : true);
          rw[q] = ok ? *(const bf16x8*)(ZA + (size_t)(tok0 - 1 + q) * ZAW + col) : z;
        }
#pragma unroll
        for (int i4 = 0; i4 < 4; ++i4)
#pragma unroll
          for (int e = 0; e < 8; ++e)
            res[sa][i4][e] = cw3[sa][0][e] * bf2f((u16)rw[i4][e]) + cw3[sa][1][e] * bf2f((u16)rw[i4 + 1][e]) + cw3[sa][2][e] * bf2f((u16)rw[i4 + 2][e]);
      }
#pragma unroll
      for (int i4 = 0; i4 < 4; ++i4) {
        const int tok = tok0 + i4;
        u32x4 o;
        o.x = cvt_pk_bf16(res[0][i4][0], res[0][i4][1]); o.y = cvt_pk_bf16(res[0][i4][2], res[0][i4][3]); o.z = cvt_pk_bf16(res[0][i4][4], res[0][i4][5]); o.w = cvt_pk_bf16(res[0][i4][6], res[0][i4][7]);
        *(u32x4*)(RC + (size_t)tok * 1024 + cbase) = o;
        o.x = cvt_pk_bf16(res[1][i4][0], res[1][i4][1]); o.y = cvt_pk_bf16(res[1][i4][2], res[1][i4][3]); o.z = cvt_pk_bf16(res[1][i4][4], res[1][i4][5]); o.w = cvt_pk_bf16(res[1][i4][6], res[1][i4][7]);
        *(u32x4*)(KC + (size_t)tok * 1024 + cbase) = o;
        o.x = cvt_pk_bf16(res[2][i4][0], res[2][i4][1]); o.y = cvt_pk_bf16(res[2][i4][2], res[2][i4][3]); o.z = cvt_pk_bf16(res[2][i4][4], res[2][i4][5]); o.w = cvt_pk_bf16(res[2][i4][6], res[2][i4][7]);
        *(u32x4*)(VC + (size_t)tok * 1024 + cbase) = o;
        float ss = 0, bd = 0;
#pragma unroll
        for (int e = 0; e < 8; ++e) {
          float kk = res[1][i4][e] * kkw[e];
          ss += kk * kk;
          bd += res[0][i4][e] * res[1][i4][e] * rkw[e];
        }
        ss = red8(ss);
        bd = red8(bd);
        if (i == 0) {
          RN[tok * 16 + h] = rsqrtf(fmaxf(ss, 1e-12f));
          BD[tok * 16 + h] = bd;
        }
      }
    }
  }
  for (int u = gt; u < NTOK * 16; u += gs) {
    const int tok = u >> 4, jv = u & 15;
    int t, T;
    if (tok < NCTX) { t = tok & 255; T = 256; } else { t = (tok - NCTX) & 1023; T = 1024; }
    const int col = 3072 + jv * 8;
    bf16x8 z = {0, 0, 0, 0, 0, 0, 0, 0};
    bf16x8 c1 = *(const bf16x8*)(ZA + (size_t)tok * ZAW + col);
    bf16x8 c0 = (t > 0) ? *(const bf16x8*)(ZA + (size_t)(tok - 1) * ZAW + col) : z;
    bf16x8 c2 = (t < T - 1) ? *(const bf16x8*)(ZA + (size_t)(tok + 1) * ZAW + col) : z;
    bf16x8 o;
#pragma unroll
    for (int e = 0; e < 8; ++e) {
      float w0 = p.conv_a[col + e], w1 = p.conv_a[ZAW + col + e], w2 = p.conv_a[2 * ZAW + col + e];
      float r = w0 * bf2f((u16)c0[e]) + w1 * bf2f((u16)c1[e]) + w2 * bf2f((u16)c2[e]);
      if (jv < 8) r = tanhf(r);
      o[e] = (short)f2bf(r);
    }
    *(bf16x8*)(WA + (size_t)tok * 128 + jv * 8) = o;
  }
  {
    const float* rcos = (const float*)(p.ws + OFF_ROPE);
    const float* rsin = rcos + 1024;
    const u16* KL = (const u16*)(p.ws + OFF_KL);
    for (int u = gt; u < 425984; u += gs) {
      bf16x8 o;
      if (u < 294912) {
        const bool isc = u < 262144;
        const int v = isc ? u : u - 262144;
        const float* src = (isc ? p.out + OUT_NEWK : p.cache_k) + (size_t)v * 8;
        const float4 a = *(const float4*)src, b4 = *(const float4*)(src + 4);
        u32x4 w; w.x = cvt_pk_bf16(a.x, a.y); w.y = cvt_pk_bf16(a.z, a.w); w.z = cvt_pk_bf16(b4.x, b4.y); w.w = cvt_pk_bf16(b4.z, b4.w);
        *(u32x4*)((u16*)(p.ws + (isc ? OFF_KBC : OFF_KBK)) + (size_t)v * 8) = w;
      } else {
        const int v = u - 294912, d8 = (v & 7) * 8, row = v >> 3;
        const int t = row & 1023, bh = row >> 10, b = bh >> 2, hk = bh & 3;
        const size_t rowo = ((size_t)b * 1024 + t) * 256 + hk * 64;
        const bf16x8 x = *(const bf16x8*)(KL + rowo + d8);
        const bf16x8 xp = *(const bf16x8*)(KL + rowo + (d8 ^ 16));
        const int pos = (d8 >= 32) ? (t & 63) : (t >> 6);
        const bool lo = (d8 & 16) == 0;
#pragma unroll
        for (int e = 0; e < 8; ++e) {
          const int i = (d8 & 8) + e;
          const float cs = rcos[pos * 16 + i], sn = rsin[pos * 16 + i];
          const float a = bf2f((u16)x[e]), bpart = bf2f((u16)xp[e]);
          o[e] = (short)f2bf(lo ? (a * cs - bpart * sn) : (bpart * sn + a * cs));
        }
        *(bf16x8*)((u16*)(p.ws + OFF_KBL) + (size_t)row * 64 + d8) = o;
      }
    }
    const u16* VL = (const u16*)(p.ws + OFF_VL);
    float* sm = (float*)smem_raw;
    const int tid = threadIdx.x;
    for (int it = blockIdx.x; it < 832; it += gridDim.x) {
      const int key = tid >> 3, d8 = (tid & 7) * 8;
      float f[8];
      u16* dst;
      int Tk, t0;
      if (it < 576) {
        const bool isc = it < 512;
        const int v = isc ? it : it - 512, bh = v >> 2;
        t0 = (v & 3) * 64; Tk = 256;
        const float* src = (isc ? p.out + OUT_NEWV : p.cache_v) + ((size_t)bh * 256 + t0 + key) * 64 + d8;
        const float4 a = *(const float4*)src, b4 = *(const float4*)(src + 4);
        f[0] = a.x; f[1] = a.y; f[2] = a.z; f[3] = a.w; f[4] = b4.x; f[5] = b4.y; f[6] = b4.z; f[7] = b4.w;
        dst = (u16*)(p.ws + (isc ? OFF_VTC : OFF_VTK)) + (size_t)bh * 64 * 256;
      } else {
        const int v = it - 576, bh = v >> 4, b = bh >> 2, hk = bh & 3;
        t0 = (v & 15) * 64; Tk = 1024;
        const bf16x8 x = *(const bf16x8*)(VL + ((size_t)b * 1024 + t0 + key) * 256 + hk * 64 + d8);
#pragma unroll
        for (int e = 0; e < 8; ++e) f[e] = bf2f((u16)x[e]);
        dst = (u16*)(p.ws + OFF_VTL) + (size_t)bh * 64 * 1024;
      }
#pragma unroll
      for (int e = 0; e < 8; ++e) sm[key * 65 + d8 + e] = f[e];
      __syncthreads();
      {
        const int d = tid >> 3, k8 = (tid & 7) * 8;
        u32x4 w;
        w.x = cvt_pk_bf16(sm[(k8 + 0) * 65 + d], sm[(k8 + 1) * 65 + d]); w.y = cvt_pk_bf16(sm[(k8 + 2) * 65 + d], sm[(k8 + 3) * 65 + d]);
        w.z = cvt_pk_bf16(sm[(k8 + 4) * 65 + d], sm[(k8 + 5) * 65 + d]); w.w = cvt_pk_bf16(sm[(k8 + 6) * 65 + d], sm[(k8 + 7) * 65 + d]);
        *(u32x4*)(dst + (size_t)d * Tk + t0 + k8) = w;
      }
      __syncthreads();
    }
  }
}


constexpr int S3_AH = 0, S3_RH = 2304, S3_VT = 4608, S3_BKT = 7680, S3_D15 = 12800, SET3_B = 13056;
constexpr int S2_BH = 0, S2_KH = 2304, SET2_B = 4608;
constexpr int G_ABF = 0, G_ABO = 256, G_AKH = 1024, G_RBH = 1792, G_RKH = 2560, GRAM_B = 3584;
constexpr int O_SET3 = 0, O_SET2 = 3 * SET3_B, O_GRAM = O_SET2 + 2 * SET2_B, O_YB = O_GRAM + 2 * GRAM_B;
constexpr int CH_BYTES = O_YB + 2 * 4096;
static_assert(2 * CH_BYTES <= 131072, "scan LDS overflow");

__device__ __forceinline__ bf16x8 pack8(uint2 lo, uint2 hi) {
  u32x4 t = {lo.x, lo.y, hi.x, hi.y};
  return __builtin_bit_cast(bf16x8, t);
}
#define LDSBAR() do { asm volatile("s_waitcnt lgkmcnt(0)" ::: "memory"); __builtin_amdgcn_s_barrier(); asm volatile("" ::: "memory"); } while (0)

struct ScanK {
  const u16 *RC, *KC, *VC, *WA;
  const float* RN;
  unsigned oWA, oRC, oRN;
  u16* Y;
  const u16* Yo;
  const float* BD;
  u16* GA;
  int d, cw, fr, fq, kcol, ch, h, ctid;
  float w0v, a0v, kkc, kac;
  float lw[4], lb[4];
};
struct ScanPre { bf16x8 paw[2], paa[2]; u16 prc[4], pkc[4], pvc[4]; float prn[4]; };

template <int D>
__device__ __forceinline__ void scan_load(ScanK& k, ScanPre& r) {
#pragma unroll
  for (int ks = 0; ks < 2; ++ks) {
    r.paw[ks] = *(const bf16x8*)(k.WA + k.oWA + ks * 32);
    r.paa[ks] = *(const bf16x8*)(k.WA + k.oWA + 64 + ks * 32);
  }
#pragma unroll
  for (int j = 0; j < 4; ++j) {
    r.prc[j] = k.RC[k.oRC + j * 1024]; r.pkc[j] = k.KC[k.oRC + j * 1024]; r.pvc[j] = k.VC[k.oRC + j * 1024];
    r.prn[j] = k.RN[k.oRN + j * 16];
  }
  if (D) { k.oWA -= 16 * 128; k.oRC -= 16 * 1024; k.oRN -= 16 * 16; }
  else { k.oWA += 16 * 128; k.oRC += 16 * 1024; k.oRN += 16 * 16; }
}

template <int D>
__device__ __forceinline__ void scan_s0(const ScanK& k, const ScanPre& r, const bf16x8 (&bw)[2], const bf16x8 (&ba)[2], char* set3, char* set2) {
  u16* AH = (u16*)(set3 + S3_AH); u16* RH = (u16*)(set3 + S3_RH); u16* VT = (u16*)(set3 + S3_VT); u16* BKT = (u16*)(set3 + S3_BKT);
  float* D15 = (float*)(set3 + S3_D15);
  u16* BH = (u16*)(set2 + S2_BH); u16* KH = (u16*)(set2 + S2_KH);
  constexpr int d = D;
  const int fq = k.fq, fr = k.fr, kcol = k.kcol;
  f32x4 accw = {0, 0, 0, 0}, acca = {0, 0, 0, 0};
#pragma unroll
  for (int ks = 0; ks < 2; ++ks) {
    accw = __builtin_amdgcn_mfma_f32_16x16x32_bf16(r.paw[ks], bw[ks], accw, 0, 0, 0);
    acca = __builtin_amdgcn_mfma_f32_16x16x32_bf16(r.paa[ks], ba[ks], acca, 0, 0, 0);
  }
  float fa[4], fb[4], fk[4], frr[4], fw[4], fv[4];
#pragma unroll
  for (int j = 0; j < 4; ++j) {
    const float rc = bf2f(r.prc[j]), kc = bf2f(r.pkc[j]);
    fv[j] = bf2f(r.pvc[j]);
    const float e = 0.60653066f * sigmoidf_(k.w0v + accw[j]);
    fw[j] = __expf(-e);
    const float av = sigmoidf_(k.a0v + acca[j]);
    const float kkv = kc * k.kkc * r.prn[j];
    fa[j] = -kkv; fb[j] = kkv * av; fk[j] = kc * (1.f + (av - 1.f) * k.kac); frr[j] = rc;
  }
  float ER[4], EA[4];
  if (d == 0) { ER[0] = fw[0]; ER[1] = ER[0] * fw[1]; ER[2] = ER[1] * fw[2]; ER[3] = ER[2] * fw[3]; }
  else { ER[3] = fw[3]; ER[2] = ER[3] * fw[2]; ER[1] = ER[2] * fw[1]; ER[0] = ER[1] * fw[0]; }
  const float tot = d ? ER[0] : ER[3];
  const float g0 = __shfl(tot, fr), g1 = __shfl(tot, fr + 16), g2 = __shfl(tot, fr + 32), g3 = __shfl(tot, fr + 48);
  const float D15v = (g0 * g1) * (g2 * g3);
  float off;
  if (d == 0) off = (fq > 0 ? g0 : 1.f) * (fq > 1 ? g1 : 1.f) * (fq > 2 ? g2 : 1.f);
  else off = (fq < 3 ? g3 : 1.f) * (fq < 2 ? g2 : 1.f) * (fq < 1 ? g1 : 1.f);
#pragma unroll
  for (int j = 0; j < 4; ++j) ER[j] *= off;
  if (d == 0) { EA[0] = off; EA[1] = ER[0]; EA[2] = ER[1]; EA[3] = ER[2]; }
  else { EA[3] = off; EA[2] = ER[3]; EA[1] = ER[2]; EA[0] = ER[1]; }
  float btv[4], ktv[4];
#pragma unroll
  for (int j = 0; j < 4; ++j) {
    const int tkn = fq * 4 + j, jj = d ? 15 - tkn : tkn;
    const float inv = __builtin_amdgcn_rcpf(ER[j]), EE = inv * D15v;
    const unsigned p1 = cvt_pk_bf16(fa[j] * EA[j], frr[j] * ER[j]);
    const unsigned p2 = cvt_pk_bf16(fb[j] * inv, fk[j] * inv);
    AH[jj * 72 + kcol] = (u16)(p1 & 0xffffu);
    RH[jj * 72 + kcol] = (u16)(p1 >> 16);
    BH[jj * 72 + kcol] = (u16)(p2 & 0xffffu);
    KH[jj * 72 + kcol] = (u16)(p2 >> 16);
    btv[j] = fb[j] * EE;
    ktv[j] = fk[j] * EE;
  }
  const int jj0 = d ? 12 - fq * 4 : fq * 4;
  uint2 pb, pk, pv;
  if (d == 0) {
    pb.x = cvt_pk_bf16(btv[0], btv[1]); pb.y = cvt_pk_bf16(btv[2], btv[3]);
    pk.x = cvt_pk_bf16(ktv[0], ktv[1]); pk.y = cvt_pk_bf16(ktv[2], ktv[3]);
    pv.x = cvt_pk_bf16(fv[0], fv[1]); pv.y = cvt_pk_bf16(fv[2], fv[3]);
  } else {
    pb.x = cvt_pk_bf16(btv[3], btv[2]); pb.y = cvt_pk_bf16(btv[1], btv[0]);
    pk.x = cvt_pk_bf16(ktv[3], ktv[2]); pk.y = cvt_pk_bf16(ktv[1], ktv[0]);
    pv.x = cvt_pk_bf16(fv[3], fv[2]); pv.y = cvt_pk_bf16(fv[1], fv[0]);
  }
  *(uint2*)(BKT + kcol * 40 + jj0) = pb;
  *(uint2*)(BKT + kcol * 40 + 16 + jj0) = pk;
  *(uint2*)(VT + kcol * 24 + jj0) = pv;
  if (fq == 0) D15[kcol] = D15v;
}

__device__ __forceinline__ void scan_s3(const ScanK& k, const char* set3, const char* set2, char* gram) {
  const int cw = k.cw, fr = k.fr, fq = k.fq;
  const u16* Asrc = (const u16*)(set3 + ((cw < 2) ? S3_AH : S3_RH));
  const u16* Bsrc = (const u16*)(set2 + ((cw & 1) ? S2_KH : S2_BH));
  float* ABF = (float*)(gram + G_ABF);
  u16* ABO = (u16*)(gram + G_ABO); u16* AKH = (u16*)(gram + G_AKH); u16* RBH = (u16*)(gram + G_RBH); u16* RKH = (u16*)(gram + G_RKH);
  f32x4 g = {0, 0, 0, 0};
#pragma unroll
  for (int ks = 0; ks < 2; ++ks) {
    bf16x8 af = *(const bf16x8*)(Asrc + fr * 72 + ks * 32 + fq * 8);
    bf16x8 bf_ = *(const bf16x8*)(Bsrc + fr * 72 + ks * 32 + fq * 8);
    g = __builtin_amdgcn_mfma_f32_16x16x32_bf16(af, bf_, g, 0, 0, 0);
  }
  u16* dstw = ABO + cw * 384;
  const int incl = cw >> 1;
  const bool samebk = (cw == 0) && ((fr >> 2) == fq);
#pragma unroll
  for (int j = 0; j < 4; ++j) {
    const int jrow = fq * 4 + j;
    const float val = (fr < jrow + incl) ? g[j] : 0.f;
    dstw[jrow * 24 + fr] = samebk ? (u16)0 : f2bf(val);
    if (samebk) ABF[jrow * 4 + (fr & 3)] = val;
  }
  (void)AKH; (void)RBH; (void)RKH;
}

template <int D>
__device__ __forceinline__ void scan_s5(const ScanK& k, f32x4 (&Zt)[4], const char* set3, const char* gram, float* YB) {
  const u16* AH = (const u16*)(set3 + S3_AH); const u16* RH = (const u16*)(set3 + S3_RH); const u16* VT = (const u16*)(set3 + S3_VT);
  const u16* BKT = (const u16*)(set3 + S3_BKT); const float* D15 = (const float*)(set3 + S3_D15);
  const float* ABF = (const float*)(gram + G_ABF);
  const u16* ABO = (const u16*)(gram + G_ABO); const u16* AKH = (const u16*)(gram + G_AKH); const u16* RBH = (const u16*)(gram + G_RBH); const u16* RKH = (const u16*)(gram + G_RKH);
  constexpr int d = D;
  const int fr = k.fr, fq = k.fq, kcol = k.kcol;
  const uint2 z2 = make_uint2(0u, 0u);
  bf16x8 zb[2];
#pragma unroll
  for (int ks = 0; ks < 2; ++ks) {
    uint2 lo, hi;
    lo.x = cvt_pk_bf16(Zt[2 * ks][0], Zt[2 * ks][1]); lo.y = cvt_pk_bf16(Zt[2 * ks][2], Zt[2 * ks][3]);
    hi.x = cvt_pk_bf16(Zt[2 * ks + 1][0], Zt[2 * ks + 1][1]); hi.y = cvt_pk_bf16(Zt[2 * ks + 1][2], Zt[2 * ks + 1][3]);
    zb[ks] = pack8(lo, hi);
  }
  f32x4 accX = {0, 0, 0, 0}, accY = {0, 0, 0, 0};
#pragma unroll
  for (int ks = 0; ks < 2; ++ks) {
    bf16x8 aA = pack8(*(const uint2*)(AH + fr * 72 + (2 * ks) * 16 + fq * 4), *(const uint2*)(AH + fr * 72 + (2 * ks + 1) * 16 + fq * 4));
    bf16x8 aR = pack8(*(const uint2*)(RH + fr * 72 + (2 * ks) * 16 + fq * 4), *(const uint2*)(RH + fr * 72 + (2 * ks + 1) * 16 + fq * 4));
    accX = __builtin_amdgcn_mfma_f32_16x16x32_bf16(aA, zb[ks], accX, 0, 0, 0);
    accY = __builtin_amdgcn_mfma_f32_16x16x32_bf16(aR, zb[ks], accY, 0, 0, 0);
  }
  const uint2 vv8 = *(const uint2*)(VT + kcol * 24 + fq * 4);
  accX = __builtin_amdgcn_mfma_f32_16x16x16bf16_1k(__builtin_bit_cast(bf16x4, *(const uint2*)(AKH + fr * 24 + fq * 4)), __builtin_bit_cast(bf16x4, vv8), accX, 0, 0, 0);
  uint2 s2 = z2;
  {
    const float4 d1 = *(const float4*)(ABF + (fq * 4 + 1) * 4), d2 = *(const float4*)(ABF + (fq * 4 + 2) * 4), d3 = *(const float4*)(ABF + (fq * 4 + 3) * 4);
    const bf16x4 aAb = __builtin_bit_cast(bf16x4, *(const uint2*)(ABO + fr * 24 + fq * 4));
    const float T10 = d1.x, T21 = d2.y, T32 = d3.z;
    const float T20 = d2.x + d2.y * d1.x;
    const float T31 = d3.y + d3.z * d2.y;
    const float T30 = d3.x + d3.y * d1.x + d3.z * T20;
    f32x4 accS = accX;
#pragma unroll
    for (int q = 0; q < 4; ++q) {
      const float t0 = accS[0];
      const float t1 = accS[1] + T10 * t0;
      const float t2 = accS[2] + T20 * t0 + T21 * accS[1];
      const float t3 = accS[3] + T30 * t0 + T31 * accS[1] + T32 * accS[2];
      uint2 pk;
      pk.x = cvt_pk_bf16(t0, t1); pk.y = cvt_pk_bf16(t2, t3);
      if (fq == q) s2 = pk;
      if (q < 3) {
        const uint2 m = (fq == q) ? pk : z2;
        accS = __builtin_amdgcn_mfma_f32_16x16x16bf16_1k(aAb, __builtin_bit_cast(bf16x4, m), accS, 0, 0, 0);
      }
    }
  }
  const bf16x8 sb = pack8(s2, vv8);
  accY = __builtin_amdgcn_mfma_f32_16x16x32_bf16(pack8(*(const uint2*)(RBH + fr * 24 + fq * 4), *(const uint2*)(RKH + fr * 24 + fq * 4)), sb, accY, 0, 0, 0);
#pragma unroll
  for (int j = 0; j < 4; ++j) {
    const int jrow = fq * 4 + j, tkn = d ? 15 - jrow : jrow;
    YB[tkn * 64 + kcol] = accY[j];
  }
#pragma unroll
  for (int kt = 0; kt < 4; ++kt) {
    const float4 dd = *(const float4*)(D15 + kt * 16 + fq * 4);
    f32x4 z = Zt[kt];
    z[0] *= dd.x; z[1] *= dd.y; z[2] *= dd.z; z[3] *= dd.w;
    const u16* bk = BKT + (kt * 16 + fr) * 40 + fq * 4;
    Zt[kt] = __builtin_amdgcn_mfma_f32_16x16x32_bf16(pack8(*(const uint2*)bk, *(const uint2*)(bk + 16)), sb, z, 0, 0, 0);
  }
}

struct FlushPre { uint2 yo, vc, ga; float bd; };
__device__ __forceinline__ void scan_flush_load(const ScanK& k, FlushPre& f, int tb) {
  const int tkn = k.ctid >> 4, k4 = (k.ctid & 15) * 4;
  const size_t tok = (size_t)(tb + tkn);
  f.yo = *(const uint2*)(k.Yo + tok * 1024 + k.h * 64 + k4);
  f.vc = *(const uint2*)(k.VC + tok * 1024 + k.h * 64 + k4);
  f.ga = *(const uint2*)(k.GA + tok * 2048 + k.h * 64 + k4);
  f.bd = k.BD[tok * 16 + k.h];
}
__device__ __forceinline__ void scan_flush_fin(const ScanK& k, const FlushPre& f, const float* YB, int tb, bool second) {
  const int tkn = k.ctid >> 4, k4 = (k.ctid & 15) * 4;
  const float4 yv = *(const float4*)(YB + tkn * 64 + k4);
  const size_t tok = (size_t)(tb + tkn);
  if (!second) {
    uint2 o;
    o.x = cvt_pk_bf16(yv.x, yv.y);
    o.y = cvt_pk_bf16(yv.z, yv.w);
    *(uint2*)(k.Y + tok * 1024 + k.h * 64 + k4) = o;
  } else {
    const uint2 yo = f.yo, vc = f.vc, ga = f.ga;
    const float bd = f.bd;
    const float y0 = yv.x + bflo(yo.x), y1 = yv.y + bfhi(yo.x), y2 = yv.z + bflo(yo.y), y3 = yv.w + bfhi(yo.y);
    const float s1 = red16(y0 + y1 + y2 + y3);
    const float s2 = red16(y0 * y0 + y1 * y1 + y2 * y2 + y3 * y3);
    const float mu = s1 * (1.f / 64.f);
    const float var = fmaxf(s2 * (1.f / 64.f) - mu * mu, 0.f);
    const float rstd = rsqrtf(var + 64e-5f);
    const float o0 = ((y0 - mu) * rstd * k.lw[0] + k.lb[0] + bd * bflo(vc.x)) * bflo(ga.x);
    const float o1 = ((y1 - mu) * rstd * k.lw[1] + k.lb[1] + bd * bfhi(vc.x)) * bfhi(ga.x);
    const float o2 = ((y2 - mu) * rstd * k.lw[2] + k.lb[2] + bd * bflo(vc.y)) * bflo(ga.y);
    const float o3 = ((y3 - mu) * rstd * k.lw[3] + k.lb[3] + bd * bfhi(vc.y)) * bfhi(ga.y);
    uint2 o;
    o.x = cvt_pk_bf16(o0, o1);
    o.y = cvt_pk_bf16(o2, o3);
    *(uint2*)(k.GA + tok * 2048 + k.h * 64 + k4) = o;
  }
}
__device__ __forceinline__ void scan_flush(const ScanK& k, const float* YB, int tb, bool second) {
  FlushPre f;
  f.yo = make_uint2(0u, 0u); f.vc = f.yo; f.ga = f.yo; f.bd = 0.f;
  if (second) scan_flush_load(k, f, tb);
  scan_flush_fin(k, f, YB, tb, second);
}

template <int D>
__device__ __forceinline__ void scan_chain(const Params& p, bool latent, int idx, int tid) {
  const int lane = tid & 63;
  const int b = idx >> 4;
  ScanK k;
  k.d = D; k.ctid = tid & 255; k.cw = __builtin_amdgcn_readfirstlane((tid >> 6) & 3); k.fr = lane & 15; k.fq = lane >> 4; k.h = idx & 15;
  k.kcol = 16 * k.cw + k.fr; k.ch = k.h * 64 + k.kcol;
  constexpr int d = D;
  const int ch = k.ch;
  const int T = latent ? 1024 : 256;
  const int tok0 = latent ? NCTX + b * 1024 : b * 256;
  char* cs = smem_raw + d * CH_BYTES;
  k.RC = (const u16*)(p.ws + OFF_H); k.KC = (const u16*)(p.ws + OFF_KC); k.VC = (const u16*)(p.ws + OFF_VC);
  k.WA = (const u16*)(p.ws + OFF_WA); k.RN = (const float*)(p.ws + OFF_RN);
  {
    const int tb0 = tok0 + (D ? (T >> 4) - 1 : 0) * 16;
    k.oWA = (unsigned)((tb0 + k.fr) * 128 + k.fq * 8);
    k.oRC = (unsigned)((tb0 + k.fq * 4) * 1024 + ch);
    k.oRN = (unsigned)((tb0 + k.fq * 4) * 16 + k.h);
  }
  k.Y = (u16*)(p.ws + OFF_ZA + (size_t)d * SZ_ACT);
  k.Yo = (const u16*)(p.ws + OFF_ZA + (size_t)(1 - d) * SZ_ACT);
  k.BD = (const float*)(p.ws + OFF_BD);
  k.GA = (u16*)(p.ws + OFF_AQ);
#pragma unroll
  for (int e = 0; e < 4; ++e) { k.lw[e] = p.ln_w[k.h * 64 + (k.ctid & 15) * 4 + e]; k.lb[e] = p.ln_b[k.h * 64 + (k.ctid & 15) * 4 + e]; }
  k.w0v = p.w0[d * 1024 + ch]; k.a0v = p.a0[d * 1024 + ch]; k.kkc = p.k_k[ch]; k.kac = p.k_a[ch];
  bf16x8 bw[2], ba[2];
#pragma unroll
  for (int ks = 0; ks < 2; ++ks)
#pragma unroll
    for (int e = 0; e < 8; ++e) {
      int l = ks * 32 + k.fq * 8 + e;
      bw[ks][e] = (short)f2bf(p.w_up[(size_t)(d * 64 + l) * 1024 + ch]);
      ba[ks][e] = (short)f2bf(p.a_up[(size_t)(d * 64 + l) * 1024 + ch]);
    }
  f32x4 Zt[4];
  if (latent) {
    const float* s0 = p.state + ((size_t)(b * 2 + d) * 16 + k.h) * 4096 + k.kcol * 64 + k.fq * 4;
#pragma unroll
    for (int kt = 0; kt < 4; ++kt) Zt[kt] = *(const f32x4*)(s0 + kt * 16);
  } else {
#pragma unroll
    for (int kt = 0; kt < 4; ++kt) Zt[kt] = (f32x4){0.f, 0.f, 0.f, 0.f};
  }
  const int nc = T >> 4;
#define TB(c) (tok0 + (d ? nc - 1 - (c) : (c)) * 16)
#define SET3(c) (cs + O_SET3 + ((c) % 3) * SET3_B)
#define SET2(c) (cs + O_SET2 + ((c) & 1) * SET2_B)
#define GRAM(c) (cs + O_GRAM + ((c) & 1) * GRAM_B)
#define YBUF(c) ((float*)(cs + O_YB + ((c) & 1) * 4096))
  ScanPre r;
  scan_load<D>(k, r);
  scan_s0<D>(k, r, bw, ba, SET3(0), SET2(0));
  scan_load<D>(k, r);
  LDSBAR();
  scan_s3(k, SET3(0), SET2(0), GRAM(0));
  scan_s0<D>(k, r, bw, ba, SET3(1), SET2(1));
  scan_load<D>(k, r);
  LDSBAR();
  const int hc = nc >> 1;
  int m3 = 0;
  for (int i = 0; i < nc - 2; ++i) {
    const int m3b = (m3 == 2) ? 0 : m3 + 1, m3c = (m3b == 2) ? 0 : m3b + 1;
    FlushPre fpre;
    fpre.yo = make_uint2(0u, 0u); fpre.vc = fpre.yo; fpre.ga = fpre.yo; fpre.bd = 0.f;
    const bool fsec = (i - 1) >= hc;
    if (i > 0 && fsec) scan_flush_load(k, fpre, TB(i - 1));
    scan_s5<D>(k, Zt, cs + O_SET3 + m3 * SET3_B, GRAM(i), YBUF(i));
    scan_s3(k, cs + O_SET3 + m3b * SET3_B, SET2(i + 1), GRAM(i + 1));
    scan_s0<D>(k, r, bw, ba, cs + O_SET3 + m3c * SET3_B, SET2(i));
    if (i + 3 < nc) scan_load<D>(k, r);
    if (i > 0) scan_flush_fin(k, fpre, YBUF(i - 1), TB(i - 1), fsec);
    if (i == hc) asm volatile("s_waitcnt vmcnt(0)" ::: "memory");
    LDSBAR();
    m3 = m3b;
  }
  {
    const int i = nc - 2;
    scan_flush(k, YBUF(i - 1), TB(i - 1), true);
    scan_s5<D>(k, Zt, SET3(i), GRAM(i), YBUF(i));
    scan_s3(k, SET3(i + 1), SET2(i + 1), GRAM(i + 1));
    LDSBAR();
  }
  {
    const int i = nc - 1;
    scan_flush(k, YBUF(i - 1), TB(i - 1), true);
    scan_s5<D>(k, Zt, SET3(i), GRAM(i), YBUF(i));
    LDSBAR();
    scan_flush(k, YBUF(i), TB(i), true);
  }
#undef TB
#undef SET3
#undef SET2
#undef GRAM
#undef YBUF
  if (!latent) {
    float* so = p.out + OUT_STATE + ((size_t)(b * 2 + d) * 16 + k.h) * 4096 + k.kcol * 64 + k.fq * 4;
#pragma unroll
    for (int kt = 0; kt < 4; ++kt) *(f32x4*)(so + kt * 16) = Zt[kt];
  }
  __syncthreads();
}

__device__ __forceinline__ void scan_item(const Params& p, bool latent, int idx) {
  int tid = threadIdx.x;
  asm volatile("" : "+v"(tid));
  if (__builtin_amdgcn_readfirstlane(tid >> 8)) scan_chain<1>(p, latent, idx, tid);
  else scan_chain<0>(p, latent, idx, tid);
  __syncthreads();
}

constexpr int KST = 72;
constexpr int ATT_BUF = 2 * 64 * KST * 2;

__device__ __forceinline__ void attn_item(const Params& p, bool latent, int idx) {
  int tid = threadIdx.x;
  asm volatile("" : "+v"(tid));
  const int w = __builtin_amdgcn_readfirstlane(tid >> 6), lane = tid & 63, fr = lane & 15, fq = lane >> 4;
  int b, head, qb;
  if (latent) { b = idx >> 6; head = (idx >> 2) & 15; qb = idx & 3; }
  else { b = idx >> 4; head = idx & 15; qb = 0; }
  const int hk = head >> 2;
  u16* Q = (u16*)(p.ws + OFF_AQ) + 1024;
  const u16* GB = (const u16*)(p.ws + OFF_GB);
  const float* rcos = (const float*)(p.ws + OFF_ROPE);
  const float* rsin = rcos + 1024;
  int qpos[2];
  size_t qtok[2];
  bf16x8 qf[2][2];
#pragma unroll
  for (int qt = 0; qt < 2; ++qt) {
    qpos[qt] = qb * 256 + w * 32 + qt * 16 + fr;
    qtok[qt] = latent ? (size_t)NCTX + b * 1024 + qpos[qt] : (size_t)b * 256 + qpos[qt];
#pragma unroll
    for (int ks = 0; ks < 2; ++ks) {
      bf16x8 x = *(const bf16x8*)(Q + qtok[qt] * 2048 + head * 64 + ks * 32 + fq * 8);
      if (latent) {
        bf16x8 xp = *(const bf16x8*)(Q + qtok[qt] * 2048 + head * 64 + ks * 32 + (fq ^ 2) * 8);
        const int pos = ks ? (qpos[qt] & 63) : (qpos[qt] >> 6);
#pragma unroll
        for (int e = 0; e < 8; ++e) {
          int i = (fq & 1) * 8 + e;
          float cs = rcos[pos * 16 + i], sn = rsin[pos * 16 + i];
          float a = bf2f((u16)x[e]), bpart = bf2f((u16)xp[e]);
          float o = (fq < 2) ? (a * cs - bpart * sn) : (bpart * sn + a * cs);
          x[e] = (short)f2bf(o);
        }
      }
      qf[qt][ks] = x;
    }
  }
  float m_run[2], l_run[2];
  f32x4 ot[2][4];
#pragma unroll
  for (int qt = 0; qt < 2; ++qt) {
    m_run[qt] = p.sink[head]; l_run[qt] = 1.f;
#pragma unroll
    for (int dt = 0; dt < 4; ++dt) ot[qt][dt] = (f32x4){0, 0, 0, 0};
  }
  int lt0 = 0, nloc = 0;
  if (latent) {
    int ks0 = qb * 256 - 128; if (ks0 < 0) ks0 = 0;
    int ke = qb * 256 + 384; if (ke > 1024) ke = 1024;
    lt0 = ks0 >> 6; nloc = (ke >> 6) - lt0;
  }
  const int ntile = nloc + 4;
  const int wq_lo = qb * 256 + w * 32, wq_hi = wq_lo + 31;
  const u16* KBloc = (const u16*)(p.ws + OFF_KBL) + (size_t)(b * 4 + hk) * 1024 * 64;
  const u16* VTloc = (const u16*)(p.ws + OFF_VTL) + (size_t)(b * 4 + hk) * 64 * 1024;
  const u16* KBctx = (const u16*)(p.ws + (latent ? OFF_KBK : OFF_KBC)) + (size_t)(b * 4 + hk) * 256 * 64;
  const u16* VTctx = (const u16*)(p.ws + (latent ? OFF_VTK : OFF_VTC)) + (size_t)(b * 4 + hk) * 64 * 256;
  const int lrow = tid >> 3, lc8 = (tid & 7) * 8;
  bf16x8 kreg, vreg;
#define ATT_GLOAD(tt_)                                                                      \
  do {                                                                                      \
    if ((tt_) < nloc) {                                                                     \
      const int ks_ = (lt0 + (tt_)) * 64;                                                   \
      kreg = *(const bf16x8*)(KBloc + (size_t)(ks_ + lrow) * 64 + lc8);                     \
      vreg = *(const bf16x8*)(VTloc + (size_t)lrow * 1024 + ks_ + lc8);                     \
    } else {                                                                                \
      const int ks_ = ((tt_) - nloc) * 64;                                                  \
      kreg = *(const bf16x8*)(KBctx + (size_t)(ks_ + lrow) * 64 + lc8);                     \
      vreg = *(const bf16x8*)(VTctx + (size_t)lrow * 256 + ks_ + lc8);                      \
    }                                                                                       \
  } while (0)
#define ATT_LSTORE(buf_)                                                                    \
  do {                                                                                      \
    u16* ks__ = (u16*)(smem_raw + (buf_) * ATT_BUF);                                        \
    *(bf16x8*)(ks__ + lrow * KST + lc8) = kreg;                                             \
    *(bf16x8*)(ks__ + 64 * KST + lrow * KST + lc8) = vreg;                                  \
  } while (0)
  ATT_GLOAD(0);
  ATT_LSTORE(0);
  __syncthreads();
  for (int tt = 0; tt < ntile; ++tt) {
    const bool local = tt < nloc;
    const int kstart = local ? (lt0 + tt) * 64 : (tt - nloc) * 64;
    if (tt + 1 < ntile) ATT_GLOAD(tt + 1);
    const u16* Ks = (const u16*)(smem_raw + (tt & 1) * ATT_BUF);
    const u16* Vt = Ks + 64 * KST;
    const bool active = !local || !(kstart > wq_hi + 128 || kstart + 63 < wq_lo - 128);
    if (active) {
      f32x4 st[2][4];
#pragma unroll
      for (int mt = 0; mt < 4; ++mt) {
        f32x4 a0 = {0, 0, 0, 0}, a1 = {0, 0, 0, 0};
#pragma unroll
        for (int ks = 0; ks < 2; ++ks) {
          const bf16x8 kf = *(const bf16x8*)(Ks + (mt * 16 + fr) * KST + ks * 32 + fq * 8);
          a0 = __builtin_amdgcn_mfma_f32_16x16x32_bf16(kf, qf[0][ks], a0, 0, 0, 0);
          a1 = __builtin_amdgcn_mfma_f32_16x16x32_bf16(kf, qf[1][ks], a1, 0, 0, 0);
        }
        st[0][mt] = a0; st[1][mt] = a1;
      }
      bf16x8 pb[2][2];
#pragma unroll
      for (int qt = 0; qt < 2; ++qt) {
        if (local) {
#pragma unroll
          for (int mt = 0; mt < 4; ++mt)
#pragma unroll
            for (int j = 0; j < 4; ++j) {
              int kpos = kstart + mt * 16 + fq * 4 + j;
              int df = qpos[qt] - kpos;
              if (df > 128 || df < -128) st[qt][mt][j] = -1e30f;
            }
        }
        float mx = -1e30f;
#pragma unroll
        for (int mt = 0; mt < 4; ++mt)
#pragma unroll
          for (int j = 0; j < 4; ++j) mx = fmaxf(mx, st[qt][mt][j]);
        mx = fmaxf(mx, __shfl_xor(mx, 16));
        mx = fmaxf(mx, __shfl_xor(mx, 32));
        const float m_new = fmaxf(m_run[qt], mx);
        const float alpha = __expf(m_run[qt] - m_new);
        float rs = 0;
#pragma unroll
        for (int mt = 0; mt < 4; ++mt)
#pragma unroll
          for (int j = 0; j < 4; ++j) {
            float pv = __expf(st[qt][mt][j] - m_new);
            st[qt][mt][j] = pv;
            rs += pv;
          }
        rs += __shfl_xor(rs, 16);
        rs += __shfl_xor(rs, 32);
        l_run[qt] = l_run[qt] * alpha + rs;
        m_run[qt] = m_new;
#pragma unroll
        for (int dt = 0; dt < 4; ++dt) ot[qt][dt] *= alpha;
#pragma unroll
        for (int kk = 0; kk < 2; ++kk) {
          uint2 plo, phi;
          plo.x = cvt_pk_bf16(st[qt][2 * kk][0], st[qt][2 * kk][1]); plo.y = cvt_pk_bf16(st[qt][2 * kk][2], st[qt][2 * kk][3]);
          phi.x = cvt_pk_bf16(st[qt][2 * kk + 1][0], st[qt][2 * kk + 1][1]); phi.y = cvt_pk_bf16(st[qt][2 * kk + 1][2], st[qt][2 * kk + 1][3]);
          pb[qt][kk] = pack8(plo, phi);
        }
      }
#pragma unroll
      for (int kk = 0; kk < 2; ++kk)
#pragma unroll
        for (int dt = 0; dt < 4; ++dt) {
          const u16* vr = Vt + (dt * 16 + fr) * KST + fq * 4;
          const bf16x8 vf = pack8(*(const uint2*)(vr + (2 * kk) * 16), *(const uint2*)(vr + (2 * kk + 1) * 16));
          ot[0][dt] = __builtin_amdgcn_mfma_f32_16x16x32_bf16(vf, pb[0][kk], ot[0][dt], 0, 0, 0);
          ot[1][dt] = __builtin_amdgcn_mfma_f32_16x16x32_bf16(vf, pb[1][kk], ot[1][dt], 0, 0, 0);
        }
    }
    if (tt + 1 < ntile) ATT_LSTORE((tt + 1) & 1);
    __syncthreads();
  }
#undef ATT_GLOAD
#undef ATT_LSTORE
#pragma unroll
  for (int qt = 0; qt < 2; ++qt) {
    const float inv_l = __builtin_amdgcn_rcpf(l_run[qt]);
#pragma unroll
    for (int dt = 0; dt < 4; ++dt) {
      const size_t off = qtok[qt] * 1024 + head * 64 + dt * 16 + fq * 4;
      const size_t offq = qtok[qt] * 2048 + head * 64 + dt * 16 + fq * 4;
      uint2 g = *(const uint2*)(GB + off);
      uint2 o;
      o.x = cvt_pk_bf16(ot[qt][dt][0] * inv_l * bflo(g.x), ot[qt][dt][1] * inv_l * bfhi(g.x));
      o.y = cvt_pk_bf16(ot[qt][dt][2] * inv_l * bflo(g.y), ot[qt][dt][3] * inv_l * bfhi(g.y));
      *(uint2*)(Q + offq) = o;
    }
  }
}

__device__ __forceinline__ void phase_gn(const Params& p) {
  const u16* Y0 = (const u16*)(p.ws + OFF_ZA);
  const u16* Y1 = (const u16*)(p.ws + OFF_ZA + SZ_ACT);
  const u16* VC = (const u16*)(p.ws + OFF_VC);
  const float* BD = (const float*)(p.ws + OFF_BD);
  u16* GA = (u16*)(p.ws + OFF_AQ);
  const int gt = blockIdx.x * NTHR + threadIdx.x, gs = gridDim.x * NTHR;
  const int hi = gt & 127, h = hi >> 3, cbase = h * 64 + (hi & 7) * 8;
  float lw[8], lb[8];
#pragma unroll
  for (int e = 0; e < 8; ++e) { lw[e] = p.ln_w[cbase + e]; lb[e] = p.ln_b[cbase + e]; }
  for (int u = gt; u < NTOK * 128; u += gs) {
    const int tok = u >> 7;
    const size_t off = (size_t)tok * 1024 + cbase;
    bf16x8 a = *(const bf16x8*)(Y0 + off), bq = *(const bf16x8*)(Y1 + off);
    const size_t offg = (size_t)tok * 2048 + cbase;
    bf16x8 vc = *(const bf16x8*)(VC + off), g = *(const bf16x8*)(GA + offg);
    float y[8], s1 = 0, s2 = 0;
#pragma unroll
    for (int e = 0; e < 8; ++e) {
      y[e] = bf2f((u16)a[e]) + bf2f((u16)bq[e]);
      s1 += y[e];
      s2 += y[e] * y[e];
    }
    s1 = red8(s1);
    s2 = red8(s2);
    const float mu = s1 * (1.f / 64.f);
    const float var = fmaxf(s2 * (1.f / 64.f) - mu * mu, 0.f);
    const float rstd = rsqrtf(var + 64e-5f);
    const float bd = BD[tok * 16 + h];
    bf16x8 o;
#pragma unroll
    for (int e = 0; e < 8; ++e) {
      float v = (y[e] - mu) * rstd * lw[e] + lb[e] + bd * bf2f((u16)vc[e]);
      o[e] = (short)f2bf(v * bf2f((u16)g[e]));
    }
    *(bf16x8*)(GA + offg) = o;
  }
}

__device__ __forceinline__ void phase_final(const Params& p) {
  const int lane = threadIdx.x & 63, wv = threadIdx.x >> 6;
  for (int tok = blockIdx.x * 8 + wv; tok < NTOK; tok += gridDim.x * 8) {
    float* xr = p.out + (size_t)tok * 1024;
    float4 v[4];
    float ss = 0;
#pragma unroll
    for (int i = 0; i < 4; ++i) {
      v[i] = *(const float4*)(xr + i * 256 + lane * 4);
      ss += v[i].x * v[i].x + v[i].y * v[i].y + v[i].z * v[i].z + v[i].w * v[i].w;
    }
    ss = wave_sum(ss);
    float rstd = rsqrtf(ss * (1.f / 1024.f) + 1e-6f);
#pragma unroll
    for (int i = 0; i < 4; ++i) {
      float4 nw = *(const float4*)(p.fnw + i * 256 + lane * 4);
      float4 o = make_float4(v[i].x * rstd * nw.x, v[i].y * rstd * nw.y, v[i].z * rstd * nw.z, v[i].w * rstd * nw.w);
      *(float4*)(xr + i * 256 + lane * 4) = o;
    }
  }
}

#define XB_TMO      128
#define XB_XCNT(j)  (256  + 64 * (j))
#define XB_XSUB(j)  (1280 + 64 * (j))
#define XB_XGEN(j)  (2304 + 64 * (j))
#define XB_TOP      3328
#define XB_TOPGEN   3392
#define XCD_BAR_WORDS 3456
#define XB_SPIN_CAP (1u << 18)
__device__ __forceinline__ unsigned xb_xcc_id() { return (unsigned)__builtin_amdgcn_s_getreg((3 << 11) | 20) & 0xFu; }
#define XB_SPIN(cond, bar) do { unsigned _sp = 0; while (cond) { __builtin_amdgcn_s_sleep(1); \
    if ((++_sp & 255u) == 0u) { if (xb_ld(&(bar)[XB_TMO])) break; if (_sp > XB_SPIN_CAP) { atomicAdd(&(bar)[XB_TMO], 1u); break; } } } } while (0)
struct XcdBarrier { unsigned* bar; unsigned x; volatile LAS unsigned* st; };
__device__ __forceinline__ XcdBarrier xcd_barrier_post(unsigned* bar, volatile LAS unsigned* st) {
  XcdBarrier b; b.bar = bar; b.x = xb_xcc_id(); b.st = st;
  if (threadIdx.x == 0) (void)xb_add(&bar[XB_XCNT(b.x)], 1u);
  return b;
}
__device__ __forceinline__ void xcd_barrier_complete(unsigned* bar, unsigned x, unsigned& nloc, unsigned& nx) {
  const unsigned G = gridDim.x * gridDim.y * gridDim.z;
  unsigned sum, cnt, mine, sp = 0u;
  for (;;) {
    sum = 0u; cnt = 0u; mine = 0u;
#pragma unroll
    for (unsigned j = 0; j < 16; ++j) { const unsigned c = xb_ld(&bar[XB_XCNT(j)]); sum += c; cnt += (c > 0u) ? 1u : 0u; mine = (j == x) ? c : mine; }
    if (sum == G) break;
    __builtin_amdgcn_s_sleep(1);
    if ((++sp & 255u) == 0u) { if (xb_ld(&bar[XB_TMO])) break; if (sp > XB_SPIN_CAP) { atomicAdd(&bar[XB_TMO], 1u); break; } }
  }
  nloc = mine > 0u ? mine : 1u; nx = cnt > 0u ? cnt : 1u;
}
__device__ __forceinline__ void xcd_barrier(const XcdBarrier& b) {
  asm volatile("s_waitcnt vmcnt(0)" ::: "memory");
  __syncthreads();
  if (threadIdx.x == 0) {
    unsigned* bar = b.bar;
    __builtin_amdgcn_s_waitcnt(0);
    unsigned nloc = b.st[0], nx = b.st[1];
    if (nloc == 0u) { xcd_barrier_complete(bar, b.x, nloc, nx); b.st[0] = nloc; b.st[1] = nx; }
    const unsigned old = xb_add(&bar[XB_XSUB(b.x)], 1u);
    const unsigned gen = old / nloc;
    if (old + 1u == (gen + 1u) * nloc) {
      __builtin_amdgcn_fence(__ATOMIC_RELEASE, "agent");
      asm volatile("s_waitcnt vmcnt(0)" ::: "memory");
      const unsigned og = xb_add(&bar[XB_TOP], 1u);
      const unsigned tg = og / nx;
      if (og + 1u == (tg + 1u) * nx) xb_add(&bar[XB_TOPGEN], 1u);
      else XB_SPIN(xb_ld(&bar[XB_TOPGEN]) == tg, bar);
      __builtin_amdgcn_fence(__ATOMIC_ACQUIRE, "agent");
      xb_add(&bar[XB_XGEN(b.x)], 1u);
      asm volatile("s_waitcnt vmcnt(0)" ::: "memory");
    } else {
      XB_SPIN(xb_ld(&bar[XB_XGEN(b.x)]) == gen, bar);
      __builtin_amdgcn_fence(__ATOMIC_ACQUIRE, "agent");
      asm volatile("s_waitcnt vmcnt(0)" ::: "memory");
    }
  }
  __syncthreads();
}

__global__ void __launch_bounds__(NTHR) fwd_megakernel(Params p) {
  cg::grid_group grid = cg::this_grid();
  __shared__ int s_item[4];
  if (threadIdx.x == 0) { s_item[0] = 0; s_item[1] = 0; s_item[2] = 0; s_item[3] = 0; }
  __syncthreads();
  XcdBarrier xb = xcd_barrier_post((unsigned*)(p.ws + OFF_BAR), (volatile LAS unsigned*)&s_item[2]);
#ifndef PHM
#define PHM 0xFFFF
#endif
#ifndef DUP
#define DUP 0
#endif
  if (PHM & 1) phase0(p);
  if (DUP & 1) { __syncthreads(); phase0(p); }
  if (gridDim.x > 65535u) grid.sync();
  if (threadIdx.x == 0) {
    unsigned sp = 0;
    while (xb_ld((unsigned*)(p.ws + OFF_MCNT)) < 192u) { __builtin_amdgcn_s_sleep(1); if (++sp > (1u << 22)) break; }
    __builtin_amdgcn_fence(__ATOMIC_ACQUIRE, "agent");
    asm volatile("s_waitcnt vmcnt(0)" ::: "memory");
  }
  __syncthreads();
  if (PHM & 2) phase1(p);
  if (DUP & 2) phase1(p);
  xcd_barrier(xb);
  LAS unsigned char* lds = (LAS unsigned char*)smem_raw;
  if (PHM & 4) {
    Gemm g{(const u16*)(p.ws + OFF_H), (const u16*)(p.ws + OFF_WIN), 1024, 1024, 1024, NTOK, INWP};
    StaticOrder S; S.init(NTOK, INWP, (int)gridDim.x, (int)blockIdx.x);
    EpiIn E{p.ws, p.out};
    gemm_phase<EpiIn>(lds, g, S, E);
    if (DUP & 4) { __syncthreads(); gemm_phase<EpiIn>(lds, g, S, E); }
  }
  xcd_barrier(xb);
  if (PHM & 8) phase_conv(p);
  if (DUP & 8) phase_conv(p);
  xcd_barrier(xb);
  {
    int* qctr = (int*)(p.ws + OFF_QCTR);
    for (;;) {
      __syncthreads();
      if (threadIdx.x == 0) s_item[0] = atomicAdd(qctr, 1);
      __syncthreads();
      const int item = __builtin_amdgcn_readfirstlane(s_item[0]);
      if (item >= 1344) break;
      if (item < 64) { if (PHM & 16) scan_item(p, true, item); }
      else if (item < 576) { if (PHM & 16) scan_item(p, false, item - 64); }
      else if (item < 832) { if (PHM & 32) attn_item(p, true, item - 576); }
      else { if (PHM & 32) attn_item(p, false, item - 832); }
    }
  }
  xcd_barrier(xb);
  if (PHM & 128) {
    Gemm g{(const u16*)(p.ws + OFF_AQ), (const u16*)(p.ws + OFF_WO), 2048, 2048, 2048, NTOK, 1024};
    StaticOrder S; S.init(NTOK, 1024, (int)gridDim.x, (int)blockIdx.x, 64 * EpiMerge::MF);
    EpiMerge E{(const u16*)p.out, (u16*)(p.ws + OFF_ZA + 2 * SZ_ACT)};
    gemm_phase<EpiMerge>(lds, g, S, E);
    if (DUP & 32) { __syncthreads(); gemm_phase<EpiMerge>(lds, g, S, E); }
  }
  xcd_barrier(xb);
  if (PHM & 256) {
    Gemm g{(const u16*)(p.ws + OFF_ZA + 2 * SZ_ACT), (const u16*)(p.ws + OFF_WOUT), 1024, 1024, 1024, NTOK, 1024};
    StaticOrder S; S.init(NTOK, 1024, (int)gridDim.x, (int)blockIdx.x, 64 * EpiOut::MF);
    EpiOut E{p.x_prompt, p.x_sample, (const float*)(p.ws + OFF_MOD), p.fnw, p.out, (float*)(p.ws + OFF_RSUM), (unsigned*)(p.ws + OFF_PCNT)};
    gemm_phase<EpiOut>(lds, g, S, E);
    if (DUP & 64) { __syncthreads(); gemm_phase<EpiOut>(lds, g, S, E); }
  }
}

extern "C" void kernel_launch(void* const* d_in, const int* in_sizes, int n_in, void* d_out, int out_size, void* d_ws,
                              size_t ws_size, hipStream_t stream) {
  constexpr size_t kDynLds = 131072;
  static int grid_blocks = 0;
  if (!grid_blocks) {
    int dev = 0, cus = 0, per_cu = 0;
    hipGetDevice(&dev);
    hipDeviceGetAttribute(&cus, hipDeviceAttributeMultiprocessorCount, dev);
    hipFuncSetAttribute((const void*)fwd_megakernel, hipFuncAttributeMaxDynamicSharedMemorySize, (int)kDynLds);
    hipOccupancyMaxActiveBlocksPerMultiprocessor(&per_cu, (const void*)fwd_megakernel, NTHR, kDynLds);
    if (per_cu < 1) { fprintf(stderr, "occupancy query returned %d\n", per_cu); return; }
    if (cus < 256) { fprintf(stderr, "this kernel needs >= 256 CUs (fused final-norm epilogue: one 192-row unit per workgroup)\n"); return; }
    grid_blocks = cus;
  }
  if (ws_size < WS_NEED) { fprintf(stderr, "workspace too small: %zu < %zu\n", ws_size, WS_NEED); return; }
  Params p{};
  const float** pp = (const float**)&p;
  for (int i = 0; i < 26; ++i) pp[i] = (const float*)d_in[i];
  p.out = (float*)d_out;
  p.ws = (char*)d_ws;
  hipMemsetAsync((char*)d_ws + OFF_QCTR, 0, OFF_WIN - OFF_QCTR, stream);
  void* args[] = {&p};
  hipError_t e = hipLaunchCooperativeKernel((const void*)fwd_megakernel, dim3(grid_blocks), dim3(NTHR), args, kDynLds, stream);
  if (e != hipSuccess) fprintf(stderr, "cooperative launch failed: %s (grid %d)\n", hipGetErrorString(e), grid_blocks);
}
```

```cpp
#include <hip/hip_runtime.h>
#include <hip/hip_bf16.h>
#include <hip/hip_cooperative_groups.h>
#include <cstdio>
namespace cg = cooperative_groups;

typedef unsigned short u16;
using bf16 = __hip_bfloat16;
using bf16x8 = __attribute__((ext_vector_type(8))) short;
using bf16x4 = __attribute__((ext_vector_type(4))) short;
using f32x4 = __attribute__((ext_vector_type(4))) float;
using f32x2 = __attribute__((ext_vector_type(2))) float;

constexpr int DM = 1024;
constexpr int NTOK = 12288;
constexpr int NCTX = 8192;
constexpr int INW = 8832;
constexpr int INWP = 8960;
constexpr int ZAW = 3200;
constexpr int NTHR = 512;

constexpr size_t OFF_MOD = 0;
constexpr size_t OFF_ROPE = 65536;
constexpr size_t OFF_QCTR = 81920;
constexpr size_t OFF_BAR = 98304;
constexpr size_t OFF_MCNT = 82048;
constexpr size_t OFF_PCNT = 114688;
constexpr size_t OFF_RSUM = 131072;
constexpr size_t OFF_WIN = 196608;
constexpr size_t OFF_WO = OFF_WIN + (size_t)INWP * 1024 * 2;
constexpr size_t OFF_WOUT = OFF_WO + (size_t)1024 * 2048 * 2;
constexpr size_t SZ_ACT = (size_t)NTOK * 1024 * 2;
constexpr size_t OFF_H = OFF_WOUT + (size_t)1024 * 1024 * 2;
constexpr size_t OFF_KC = OFF_H + SZ_ACT;
constexpr size_t OFF_VC = OFF_KC + SZ_ACT;
constexpr size_t OFF_ZA = OFF_VC + SZ_ACT;
constexpr size_t OFF_AQ = OFF_ZA + (size_t)NTOK * ZAW * 2;
constexpr size_t OFF_GB = OFF_AQ + 2 * SZ_ACT;
constexpr size_t OFF_KL = OFF_GB + SZ_ACT;
constexpr size_t OFF_VL = OFF_KL + (size_t)4096 * 256 * 2;
constexpr size_t OFF_WA = OFF_WIN;
constexpr size_t OFF_RN = OFF_WA + (size_t)NTOK * 128 * 2;
constexpr size_t OFF_BD = OFF_RN + (size_t)NTOK * 16 * 4;
constexpr size_t OFF_KBC = OFF_BD + (size_t)NTOK * 16 * 4;
constexpr size_t OFF_VTC = OFF_KBC + (size_t)128 * 256 * 64 * 2;
constexpr size_t OFF_KBL = OFF_VTC + (size_t)128 * 256 * 64 * 2;
constexpr size_t OFF_VTL = OFF_KBL + (size_t)16 * 1024 * 64 * 2;
constexpr size_t OFF_KBK = OFF_VTL + (size_t)16 * 1024 * 64 * 2;
constexpr size_t OFF_VTK = OFF_KBK + (size_t)16 * 256 * 64 * 2;
static_assert(OFF_VTK + (size_t)16 * 256 * 64 * 2 <= OFF_WO, "WIN region overflow");
constexpr size_t WS_NEED = OFF_VL + (size_t)4096 * 256 * 2;

constexpr size_t OUT_NEWK = (size_t)NTOK * 1024;
constexpr size_t OUT_NEWV = OUT_NEWK + (size_t)32 * 4 * 256 * 64;
constexpr size_t OUT_STATE = OUT_NEWV + (size_t)32 * 4 * 256 * 64;

struct Params {
  const float *x_prompt, *x_sample, *cache_k, *cache_v, *state, *c, *c_ctx, *norm_w, *w_ada, *b_ada, *w_in, *conv_a,
      *w0, *w_up, *a0, *a_up, *k_k, *k_a, *r_k, *ln_w, *ln_b, *w_oA, *sink, *w_oB, *w_out, *fnw;
  float* out;
  char* ws;
};

extern __shared__ __attribute__((aligned(16))) char smem_raw[];

__device__ __forceinline__ u16 f2bf(float f) {
  unsigned u = __float_as_uint(f);
  u += 0x7fffu + ((u >> 16) & 1u);
  return (u16)(u >> 16);
}
__device__ __forceinline__ float bf2f(u16 h) { return __uint_as_float(((unsigned)h) << 16); }
__device__ __forceinline__ float sigmoidf_(float x) { return __builtin_amdgcn_rcpf(1.f + __expf(-x)); }
__device__ __forceinline__ float siluf_(float x) { return x * __builtin_amdgcn_rcpf(1.f + __expf(-x)); }

__device__ __forceinline__ unsigned xb_ld(unsigned* p)              { return __hip_atomic_load(p, __ATOMIC_RELAXED, __HIP_MEMORY_SCOPE_AGENT); }
__device__ __forceinline__ unsigned xb_add(unsigned* p, unsigned v) { return __hip_atomic_fetch_add(p, v, __ATOMIC_RELAXED, __HIP_MEMORY_SCOPE_AGENT); }

typedef unsigned u32x4 __attribute__((ext_vector_type(4)));
typedef __bf16 bf16v2_t __attribute__((ext_vector_type(2)));
__device__ __forceinline__ unsigned cvt_pk_bf16(float lo, float hi) {
  f32x2 f = {lo, hi};
  bf16v2_t b = __builtin_convertvector(f, bf16v2_t);
  return __builtin_bit_cast(unsigned, b);
}

template <int CTRL>
__device__ __forceinline__ float dppf(float v) {
  return __builtin_bit_cast(float, __builtin_amdgcn_update_dpp(0, __builtin_bit_cast(int, v), CTRL, 0xf, 0xf, true));
}
__device__ __forceinline__ float red8(float v) {
  v += dppf<0xB1>(v);
  v += dppf<0x4E>(v);
  v += dppf<0x141>(v);
  return v;
}
__device__ __forceinline__ float red16(float v) {
  v = red8(v);
  v += dppf<0x140>(v);
  return v;
}
__device__ __forceinline__ float wave_sum(float v) {
  for (int o = 32; o > 0; o >>= 1) v += __shfl_xor(v, o);
  return v;
}

__device__ __forceinline__ void transpose_tile(const float* src, int lds, u16* dst, int ldd, int k0, int n0, bool zero) {
  const int tid = threadIdx.x;
  float* sm = (float*)smem_raw;
  {
    int r = tid >> 4, c4 = (tid & 15) * 4;
#pragma unroll
    for (int pass = 0; pass < 2; ++pass) {
      int rr = r + pass * 32;
      float4 v = make_float4(0, 0, 0, 0);
      if (!zero) v = *(const float4*)(src + (size_t)(k0 + rr) * lds + n0 + c4);
      sm[rr * 65 + c4 + 0] = v.x; sm[rr * 65 + c4 + 1] = v.y; sm[rr * 65 + c4 + 2] = v.z; sm[rr * 65 + c4 + 3] = v.w;
    }
  }
  __syncthreads();
  {
    int n = tid >> 3, k8 = (tid & 7) * 8;
    bf16x8 o;
#pragma unroll
    for (int e = 0; e < 8; ++e) o[e] = (short)f2bf(sm[(k8 + e) * 65 + n]);
    *(bf16x8*)(dst + (size_t)(n0 + n) * ldd + k0 + k8) = o;
  }
  __syncthreads();
}

__device__ __forceinline__ void phase0(const Params& p) {
  const int tid = threadIdx.x;
  float* mod = (float*)(p.ws + OFF_MOD);
  if (blockIdx.x == 1) {
    float* rt = (float*)(p.ws + OFF_ROPE);
    for (int idx = tid; idx < 1024; idx += NTHR) {
      int pos = idx >> 4, i = idx & 15;
      float inv = exp2f(-(float)i * (13.287712379549449f / 16.f));
      float ang = (float)pos * inv;
      rt[idx] = __cosf(ang);
      rt[1024 + idx] = __sinf(ang);
    }
  }
  float* sm = (float*)smem_raw;
  const int NMOD = 192, NTR_IN = 16 * 70, NTR = NTR_IN + 3 * 256;
  for (int item = blockIdx.x; item < NMOD + NTR; item += gridDim.x) {
    if (item < NMOD) {
      int col0 = item * 16, kg = tid >> 4, j = tid & 15;
      float* sc = sm + 4096;
#pragma unroll
      for (int q = 0; q < 10; ++q) {
        const int e = tid + q * NTHR, c = e >> 10, kx = e & 1023;
        const float cv = (c < 4) ? p.c[c * 1024 + kx] : p.c_ctx[kx];
        sc[e] = siluf_(cv);
      }
      float wv[32];
#pragma unroll
      for (int q = 0; q < 32; ++q) wv[q] = p.w_ada[(size_t)(kg * 32 + q) * 3072 + col0 + j];
      __syncthreads();
      float acc[5] = {0, 0, 0, 0, 0};
#pragma unroll
      for (int q = 0; q < 32; ++q) {
#pragma unroll
        for (int c = 0; c < 5; ++c) acc[c] += sc[c * 1024 + kg * 32 + q] * wv[q];
      }
#pragma unroll
      for (int c = 0; c < 5; ++c) sm[(kg * 5 + c) * 16 + j] = acc[c];
      __syncthreads();
      if (tid < 80) {
        int c = tid >> 4;
        float s = 0;
        for (int g = 0; g < 32; ++g) s += sm[(g * 5 + c) * 16 + j];
        mod[c * 3072 + col0 + j] = s + p.b_ada[col0 + j];
      }
      asm volatile("s_waitcnt vmcnt(0)" ::: "memory");
      __syncthreads();
      if (tid == 0) {
        __builtin_amdgcn_fence(__ATOMIC_RELEASE, "agent");
        asm volatile("s_waitcnt vmcnt(0)" ::: "memory");
        xb_add((unsigned*)(p.ws + OFF_MCNT), 1u);
      }
    } else {
      int t = item - NMOD;
      if (t < NTR_IN) {
        const int nt2 = t % 70, kt = t / 70;
        const int k0 = kt * 64, n0 = nt2 * 128;
        const int r = tid >> 4, c4 = (tid & 15) * 4;
        float4 v[2][2];
#pragma unroll
        for (int sub = 0; sub < 2; ++sub)
#pragma unroll
          for (int pass = 0; pass < 2; ++pass) {
            const int nn = n0 + sub * 64;
            v[sub][pass] = (nn < INW) ? *(const float4*)(p.w_in + (size_t)(k0 + r + pass * 32) * INW + nn + c4) : make_float4(0, 0, 0, 0);
          }
#pragma unroll
        for (int sub = 0; sub < 2; ++sub)
#pragma unroll
          for (int pass = 0; pass < 2; ++pass) {
            float* b_ = sm + sub * (64 * 65) + (r + pass * 32) * 65 + c4;
            b_[0] = v[sub][pass].x; b_[1] = v[sub][pass].y; b_[2] = v[sub][pass].z; b_[3] = v[sub][pass].w;
          }
        __syncthreads();
        {
          const int n = tid >> 3, k8 = (tid & 7) * 8;
          u16* dstp = (u16*)(p.ws + OFF_WIN);
#pragma unroll
          for (int sub = 0; sub < 2; ++sub) {
            const float* b_ = sm + sub * (64 * 65);
            u32x4 o;
            o.x = cvt_pk_bf16(b_[(k8 + 0) * 65 + n], b_[(k8 + 1) * 65 + n]); o.y = cvt_pk_bf16(b_[(k8 + 2) * 65 + n], b_[(k8 + 3) * 65 + n]);
            o.z = cvt_pk_bf16(b_[(k8 + 4) * 65 + n], b_[(k8 + 5) * 65 + n]); o.w = cvt_pk_bf16(b_[(k8 + 6) * 65 + n], b_[(k8 + 7) * 65 + n]);
            *(u32x4*)(dstp + (size_t)(n0 + sub * 64 + n) * 1024 + k0 + k8) = o;
          }
        }
        __syncthreads();
      } else {
        int u = t - NTR_IN, w = u >> 8, r = u & 255;
        int nt = r & 15, kt = r >> 4;
        if (w == 0) transpose_tile(p.w_oA, 1024, (u16*)(p.ws + OFF_WO), 2048, kt * 64, nt * 64, false);
        else if (w == 1) transpose_tile(p.w_oB, 1024, (u16*)(p.ws + OFF_WO) + 1024, 2048, kt * 64, nt * 64, false);
        else transpose_tile(p.w_out, 1024, (u16*)(p.ws + OFF_WOUT), 1024, kt * 64, nt * 64, false);
      }
    }
  }
}

__device__ __forceinline__ void phase1(const Params& p) {
  const int lane = threadIdx.x & 63, wv = threadIdx.x >> 6;
  const float* mod = (const float*)(p.ws + OFF_MOD);
  u16* H = (u16*)(p.ws + OFF_H);
  for (int tok = blockIdx.x * 8 + wv; tok < NTOK; tok += gridDim.x * 8) {
    const float* xr = (tok < NCTX) ? p.x_prompt + (size_t)tok * 1024 : p.x_sample + (size_t)(tok - NCTX) * 1024;
    int ci = (tok < NCTX) ? 4 : ((tok - NCTX) >> 10);
    float4 v[4];
    float ss = 0;
#pragma unroll
    for (int i = 0; i < 4; ++i) {
      v[i] = *(const float4*)(xr + i * 256 + lane * 4);
      ss += v[i].x * v[i].x + v[i].y * v[i].y + v[i].z * v[i].z + v[i].w * v[i].w;
    }
    ss = wave_sum(ss);
    float rstd = rsqrtf(ss * (1.f / 1024.f) + 1e-6f);
#pragma unroll
    for (int i = 0; i < 4; ++i) {
      int e = i * 256 + lane * 4;
      float4 nw = *(const float4*)(p.norm_w + e);
      float4 sh = *(const float4*)(mod + ci * 3072 + e);
      float4 sc = *(const float4*)(mod + ci * 3072 + 1024 + e);
      u16 o0 = f2bf(v[i].x * rstd * nw.x * (1.f + sc.x) + sh.x);
      u16 o1 = f2bf(v[i].y * rstd * nw.y * (1.f + sc.y) + sh.y);
      u16 o2 = f2bf(v[i].z * rstd * nw.z * (1.f + sc.z) + sh.z);
      u16 o3 = f2bf(v[i].w * rstd * nw.w * (1.f + sc.w) + sh.w);
      uint2 o;
      o.x = (unsigned)o0 | ((unsigned)o1 << 16);
      o.y = (unsigned)o2 | ((unsigned)o3 << 16);
      *(uint2*)(H + (size_t)tok * 1024 + e) = o;
    }
  }
}


#define LAS __attribute__((address_space(3)))
constexpr int BM = 256, BK = 64, HALF = 128, HTB = HALF * BK * 2, NXCD = 8, WGM = 8;
__device__ __forceinline__ int lds_byte(int r, int c) { const int st = (r >> 4) * 2 + (c >> 5), rr = r & 15, cc = c & 31, ob = rr * 64 + cc * 2; return st * 1024 + (ob ^ (((ob >> 9) & 1) << 5)); }
__device__ __forceinline__ void stage_rc(int b, int& R, int& C) { const int st = b / 1024, sb = b % 1024, swz = sb ^ (((sb >> 9) & 1) << 5); R = (st >> 1) * 16 + swz / 64; C = (st & 1) * 32 + (swz % 64) / 2; }
__device__ __forceinline__ int perm32(int rho) { const int n = rho >> 4, i = rho & 15; return 8 * (i >> 2) + 4 * n + (i & 3); }
struct Unit { int pm, pn; };
struct Gemm { const u16* A; const u16* Bt; int lda, ldb, K, M, N; };
struct StaticOrder {
  int nM, nN, nwg, G, c;
  __device__ void init(int M, int N, int G_, int c_, int rows_per_unit = BM) { nM = M / rows_per_unit; nN = N / BM; nwg = nM * nN; G = G_; c = c_; }
  __device__ bool next(int i, Unit& u) const {
    const long L = (long)i * G + c; if (L >= nwg) return false;
    int wgid = (int)L; { const int q = nwg / NXCD, r = nwg % NXCD, xcd = wgid % NXCD, off = wgid / NXCD; wgid = (xcd < r ? xcd * (q + 1) : r * (q + 1) + (xcd - r) * q) + off; }
    const int nig = WGM * nN, gid = wgid / nig, fm = gid * WGM, gsz = (nM - fm) < WGM ? (nM - fm) : WGM;
    u.pm = fm + ((wgid % nig) % gsz); u.pn = (wgid % nig) / gsz; return true;
  }
};
__device__ __forceinline__ float bflo(unsigned u) { return __uint_as_float(u << 16); }
__device__ __forceinline__ float bfhi(unsigned u) { return __uint_as_float(u & 0xffff0000u); }

struct EpiIn {
  static constexpr bool PERM = true, MID = false, AFTER_DRAIN = false;
  static constexpr int MF = 4;
  static constexpr int MIDT = 0;
  char* ws; float* out;
  __device__ __forceinline__ void mid(f32x4 (&acc)[2][2][4][2], const Unit& u, int wr, int wc, int fr, int fq) const {}
  __device__ __forceinline__ void operator()(const f32x4 (&acc)[2][2][4][2], const Unit& u, int wr, int wc, int fr, int fq) const {
    const int row0 = u.pm * BM + wr * 64 + fr;
#pragma unroll
    for (int bj = 0; bj < 2; ++bj) {
      const int cb = u.pn * BM + bj * HALF;
      const int col0 = cb + wc * 32 + 8 * fq;
      if (cb >= INW) continue;
#pragma unroll
      for (int ai = 0; ai < 2; ++ai)
#pragma unroll
        for (int m = 0; m < 4; ++m) {
          const int row = row0 + ai * HALF + m * 16;
          f32x4 v0 = acc[ai][bj][m][0], v1 = acc[ai][bj][m][1];
          if (cb >= 5248 && cb < 5760 && row < NCTX) {
            const bool isv = cb >= 5504;
            const int c = col0 - (isv ? 5504 : 5248);
            const int b = row >> 8, t = row & 255, hk = c >> 6, d = c & 63;
            float* o = out + (isv ? OUT_NEWV : OUT_NEWK) + ((size_t)(b * 4 + hk) * 256 + t) * 64 + d;
            *(f32x4*)o = v0;
            *(f32x4*)(o + 4) = v1;
            continue;
          }
          u16* dst;
          if (cb < 3200) dst = (u16*)(ws + OFF_ZA) + (size_t)row * ZAW + col0;
          else if (cb < 4224) {
            dst = (u16*)(ws + OFF_AQ) + (size_t)row * 2048 + (col0 - 3200);
#pragma unroll
            for (int j = 0; j < 4; ++j) { v0[j] = siluf_(v0[j]); v1[j] = siluf_(v1[j]); }
          } else if (cb < 5248) {
            dst = (u16*)(ws + OFF_AQ) + (size_t)row * 2048 + 1024 + (col0 - 4224);
            v0 *= 0.125f; v1 *= 0.125f;
          } else if (cb < 5504) dst = (u16*)(ws + OFF_KL) + (size_t)(row - NCTX) * 256 + (col0 - 5248);
          else if (cb < 5760) dst = (u16*)(ws + OFF_VL) + (size_t)(row - NCTX) * 256 + (col0 - 5504);
          else if (cb < 6784) {
            dst = (u16*)(ws + OFF_GB) + (size_t)row * 1024 + (col0 - 5760);
#pragma unroll
            for (int j = 0; j < 4; ++j) { v0[j] = siluf_(v0[j]); v1[j] = siluf_(v1[j]); }
          } else {
            dst = (u16*)out + (size_t)row * 2048 + (col0 - 6784);
#pragma unroll
            for (int j = 0; j < 4; ++j) { v0[j] = sigmoidf_(v0[j]); v1[j] = sigmoidf_(v1[j]); }
          }
          u32x4 w; w.x = cvt_pk_bf16(v0[0], v0[1]); w.y = cvt_pk_bf16(v0[2], v0[3]); w.z = cvt_pk_bf16(v1[0], v1[1]); w.w = cvt_pk_bf16(v1[2], v1[3]);
          *(u32x4*)dst = w;
        }
    }
  }
};
struct EpiMerge {
  static constexpr bool PERM = true, MID = true, AFTER_DRAIN = false;
  static constexpr int MIDT = 16;
  static constexpr int MF = 3;
  const u16* mamb; u16* merged;
  __device__ __forceinline__ void mid(f32x4 (&acc)[2][2][4][2], const Unit& u, int wr, int wc, int fr, int fq) const {
    int lz; asm volatile("v_mov_b32 %0, 0" : "=v"(lz));
    const int row0 = u.pm * (64 * MF) + wr * (16 * MF) + fr + lz, col0 = u.pn * BM + wc * 32 + 8 * fq;
#pragma unroll
    for (int ai = 0; ai < 2; ++ai)
#pragma unroll
      for (int m = 0; m < MF; ++m)
#pragma unroll
        for (int bj = 0; bj < 2; ++bj) {
          const u16* rp = mamb + (size_t)(row0 + ai * (32 * MF) + m * 16) * 2048 + col0 + bj * HALF;
          const u32x4 a = *(const u32x4*)rp, b = *(const u32x4*)(rp + 1024);
          f32x4 r0, r1;
#define RCPF(x) __builtin_amdgcn_rcpf(x)
          r0[0] = bflo(a.x) * RCPF(bflo(b.x)); r0[1] = bfhi(a.x) * RCPF(bfhi(b.x)); r0[2] = bflo(a.y) * RCPF(bflo(b.y)); r0[3] = bfhi(a.y) * RCPF(bfhi(b.y));
          r1[0] = bflo(a.z) * RCPF(bflo(b.z)); r1[1] = bfhi(a.z) * RCPF(bfhi(b.z)); r1[2] = bflo(a.w) * RCPF(bflo(b.w)); r1[3] = bfhi(a.w) * RCPF(bfhi(b.w));
          acc[ai][bj][m][0] *= r0;
          acc[ai][bj][m][1] *= r1;
          __builtin_amdgcn_sched_barrier(0);
        }
  }
  __device__ __forceinline__ void operator()(const f32x4 (&acc)[2][2][4][2], const Unit& u, int wr, int wc, int fr, int fq) const {
    const int row0 = u.pm * (64 * MF) + wr * (16 * MF) + fr, col0 = u.pn * BM + wc * 32 + 8 * fq;
#pragma unroll
    for (int ai = 0; ai < 2; ++ai)
#pragma unroll
      for (int m = 0; m < MF; ++m)
#pragma unroll
        for (int bj = 0; bj < 2; ++bj) {
          const size_t row = (size_t)(row0 + ai * (32 * MF) + m * 16);
          const u32x4 b = *(const u32x4*)(mamb + row * 2048 + 1024 + col0 + bj * HALF);
          const f32x4 v0 = acc[ai][bj][m][0], v1 = acc[ai][bj][m][1];
          u32x4 w;
          w.x = cvt_pk_bf16(v0[0] * bflo(b.x), v0[1] * bfhi(b.x)); w.y = cvt_pk_bf16(v0[2] * bflo(b.y), v0[3] * bfhi(b.y));
          w.z = cvt_pk_bf16(v1[0] * bflo(b.z), v1[1] * bfhi(b.z)); w.w = cvt_pk_bf16(v1[2] * bflo(b.w), v1[3] * bfhi(b.w));
          *(u32x4*)(merged + row * 1024 + col0 + bj * HALF) = w;
          __builtin_amdgcn_sched_barrier(0);
        }
  }
};
struct EpiOut {
  static constexpr bool PERM = false, MID = false, AFTER_DRAIN = true;
  static constexpr int MIDT = 0;
  static constexpr int MF = 3;
  const float *xp, *xs, *mod, *fnw; float* out; float* rsum; unsigned* pcnt;
  __device__ __forceinline__ void mid(f32x4 (&acc)[2][2][4][2], const Unit& u, int wr, int wc, int fr, int fq) const {}
  __device__ __forceinline__ void operator()(f32x4 (&acc)[2][2][4][2], const Unit& u, int wr, int wc, int fr, int fq) const {
    const int row0 = u.pm * (64 * MF) + wr * (16 * MF) + fr, col0 = u.pn * BM + wc * 32 + 4 * fq;
    {
#pragma unroll
      for (int ai = 0; ai < 2; ++ai)
#pragma unroll
        for (int m = 0; m < MF; ++m) {
          const int row = row0 + ai * (32 * MF) + m * 16;
          const float* xr = (row < NCTX) ? xp + (size_t)row * 1024 : xs + (size_t)(row - NCTX) * 1024;
          const float* gr = mod + ((row < NCTX) ? 4 : ((row - NCTX) >> 10)) * 3072 + 2048;
          float ss = 0.f;
#pragma unroll
          for (int bj = 0; bj < 2; ++bj)
#pragma unroll
            for (int n = 0; n < 2; ++n) {
              const f32x4 v = *(const f32x4*)(xr + col0 + bj * HALF + n * 16) + *(const f32x4*)(gr + col0 + bj * HALF + n * 16) * acc[ai][bj][m][n];
              acc[ai][bj][m][n] = v;
              ss += v[0] * v[0] + v[1] * v[1] + v[2] * v[2] + v[3] * v[3];
            }
          ss += __shfl_xor(ss, 16);
          ss += __shfl_xor(ss, 32);
          if (fq == 0) atomicAdd(rsum + row, ss);
        }
    }
    __syncthreads();
    if (threadIdx.x == 0) {
      __builtin_amdgcn_fence(__ATOMIC_RELEASE, "agent");
      asm volatile("s_waitcnt vmcnt(0)" ::: "memory");
      xb_add(pcnt + u.pm, 1u);
      unsigned sp = 0;
      while (xb_ld(pcnt + u.pm) < 4u) { __builtin_amdgcn_s_sleep(1); if (++sp > (1u << 22)) break; }
      __builtin_amdgcn_fence(__ATOMIC_ACQUIRE, "agent");
      asm volatile("s_waitcnt vmcnt(0)" ::: "memory");
    }
    __syncthreads();
    f32x4 w[2][2];
#pragma unroll
    for (int bj = 0; bj < 2; ++bj)
#pragma unroll
      for (int n = 0; n < 2; ++n) w[bj][n] = *(const f32x4*)(fnw + col0 + bj * HALF + n * 16);
#pragma unroll
    for (int ai = 0; ai < 2; ++ai)
#pragma unroll
      for (int m = 0; m < MF; ++m) {
        const int row = row0 + ai * (32 * MF) + m * 16;
        const float tot = __hip_atomic_load(rsum + row, __ATOMIC_RELAXED, __HIP_MEMORY_SCOPE_AGENT);
        const float rstd = rsqrtf(tot * (1.f / 1024.f) + 1e-6f);
        float* orow = out + (size_t)row * 1024;
#pragma unroll
        for (int bj = 0; bj < 2; ++bj)
#pragma unroll
          for (int n = 0; n < 2; ++n) *(f32x4*)(orow + col0 + bj * HALF + n * 16) = acc[ai][bj][m][n] * rstd * w[bj][n];
      }
  }
};

template <class Epi>
__device__ __forceinline__ void gemm_phase(LAS unsigned char* lds, const Gemm g, const StaticOrder& S, const Epi& E) {
  int tid = threadIdx.x;
  asm volatile("" : "+v"(tid));
  const int wid = __builtin_amdgcn_readfirstlane(tid >> 6), lane = tid & 63, wr = wid >> 2, wc = wid & 3, fr = lane & 15, fq = lane >> 4;
  const int nt = g.K / BK;
  unsigned voffA[2], voffB[2];
#pragma unroll
  for (int i = 0; i < 2; ++i) { int R, C; stage_rc(tid * 16 + i * 8192, R, C); const int Rb = Epi::PERM ? ((R & ~31) + perm32(R & 31)) : R;
    voffA[i] = (unsigned)(R * g.lda + C) * 2u; voffB[i] = (unsigned)(Rb * g.ldb + C) * 2u; }
  const size_t kstep = (size_t)(BK * 2);
  constexpr int MF = Epi::MF;
  const size_t hstepA = (size_t)(32 * MF) * g.lda * 2, hstepB = (size_t)HALF * g.ldb * 2;
  const size_t tstepA = 2 * hstepA, tstepB = 2 * hstepB;
  const unsigned ldsw = (unsigned)wid * 1024u;
  const int aoff = lds_byte(wr * (16 * MF) + fr, fq * 8), boff = lds_byte(wc * 32 + fr, fq * 8);
#define PG8_SA(b, h) (((b) * 2 + (h)) * HTB)
#define PG8_SB(b, h) ((4 + (b) * 2 + (h)) * HTB)
#define PG8_STAGE(bufoff, gbase, voff) do { _Pragma("unroll") for (int _i = 0; _i < 2; ++_i) \
    __builtin_amdgcn_global_load_lds((const unsigned*)((const char*)(gbase) + (voff)[_i]), (LAS unsigned*)(lds + (bufoff) + ldsw + _i * 8192), 16, 0, 0); } while (0)
#define PG8_LDA(dst, b, h) do { _Pragma("unroll") for (int m = 0; m < MF; ++m) _Pragma("unroll") for (int k = 0; k < 2; ++k) dst[m][k] = *(const LAS bf16x8*)(lds + PG8_SA(b, h) + aoff + m * 2048 + k * 1024); } while (0)
#define PG8_LDB(dst, b, h) do { _Pragma("unroll") for (int n = 0; n < 2; ++n) _Pragma("unroll") for (int k = 0; k < 2; ++k) dst[n][k] = *(const LAS bf16x8*)(lds + PG8_SB(b, h) + boff + n * 2048 + k * 1024); } while (0)
#define PG8_MMA(ai, bj, At, Bt) do { __builtin_amdgcn_s_setprio(1); _Pragma("unroll") for (int m = 0; m < MF; ++m) _Pragma("unroll") for (int n = 0; n < 2; ++n) _Pragma("unroll") for (int k = 0; k < 2; ++k) \
    acc[ai][bj][m][n] = __builtin_amdgcn_mfma_f32_16x16x32_bf16(Bt[n][k], At[m][k], acc[ai][bj][m][n], 0, 0, 0); __builtin_amdgcn_s_setprio(0); } while (0)
#define PG8_WAIT_V(n) asm volatile("s_waitcnt vmcnt(" #n ")" ::: "memory")
#define PG8_WAIT_L(n) asm volatile("s_waitcnt lgkmcnt(" #n ")" ::: "memory")
#define PG8_WAIT_LB do { if constexpr (MF == 4) PG8_WAIT_L(8); else PG8_WAIT_L(6); } while (0)
#define PG8_BAR __builtin_amdgcn_s_barrier()
#define PG8_SCHED __builtin_amdgcn_sched_barrier(0)
  Unit cur, nxt; int ui = 0;
  if (!S.next(0, cur)) return;
  f32x4 acc[2][2][4][2];
#pragma unroll
  for (int a = 0; a < 2; ++a)
#pragma unroll
    for (int b = 0; b < 2; ++b)
#pragma unroll
      for (int m = 0; m < 4; ++m)
#pragma unroll
        for (int n = 0; n < 2; ++n) acc[a][b][m][n] = (f32x4){0.f, 0.f, 0.f, 0.f};
  bf16x8 At[4][2], B0[2][2], B1[2][2];
  const char* cA = (const char*)g.A + (size_t)cur.pm * tstepA; const char* cB = (const char*)g.Bt + (size_t)cur.pn * tstepB;
  PG8_STAGE(PG8_SB(0, 0), cB, voffB); PG8_STAGE(PG8_SA(0, 0), cA, voffA); PG8_STAGE(PG8_SB(0, 1), cB + hstepB, voffB); PG8_STAGE(PG8_SA(0, 1), cA + hstepA, voffA);
  if (wr == 1) PG8_BAR;
  PG8_WAIT_V(4); PG8_BAR;
  PG8_STAGE(PG8_SB(1, 0), cB + kstep, voffB); PG8_STAGE(PG8_SA(1, 0), cA + kstep, voffA); PG8_STAGE(PG8_SB(1, 1), cB + hstepB + kstep, voffB);
  PG8_WAIT_V(6); PG8_BAR;
  for (;;) {
    const bool has_next = S.next(ui + 1, nxt);
    const char* nA = has_next ? (const char*)g.A + (size_t)nxt.pm * tstepA : cA; const char* nB = has_next ? (const char*)g.Bt + (size_t)nxt.pn * tstepB : cB;
    for (int t = 0; t < nt; t += 2) {
      const bool last = (t == nt - 2);
      const char* a1 = cA + (size_t)(t + 1) * kstep;
      const char* a2 = last ? nA : cA + (size_t)(t + 2) * kstep; const char* b2 = last ? nB : cB + (size_t)(t + 2) * kstep;
      const char* a3 = a2 + kstep; const char* b3 = b2 + kstep;
      if constexpr (Epi::MID) { if (t == Epi::MIDT) E.mid(acc, cur, wr, wc, fr, fq); }
      PG8_LDB(B0, 0, 0); PG8_SCHED; PG8_LDA(At, 0, 0); PG8_STAGE(PG8_SA(1, 1), a1 + hstepA, voffA);
      PG8_WAIT_LB; PG8_BAR; PG8_WAIT_L(0); PG8_MMA(0, 0, At, B0); PG8_BAR; PG8_SCHED;
      PG8_LDB(B1, 0, 1); PG8_STAGE(PG8_SB(0, 0), b2, voffB);
      PG8_BAR; PG8_WAIT_L(0); PG8_MMA(0, 1, At, B1); PG8_BAR;
      PG8_LDA(At, 0, 1); PG8_STAGE(PG8_SA(0, 0), a2, voffA);
      PG8_BAR; PG8_WAIT_L(0); PG8_MMA(1, 0, At, B0); PG8_BAR; PG8_SCHED;
      PG8_STAGE(PG8_SB(0, 1), b2 + hstepB, voffB);
      PG8_WAIT_V(6); PG8_BAR; PG8_MMA(1, 1, At, B1); PG8_BAR;
      PG8_LDB(B0, 1, 0); PG8_SCHED; PG8_LDA(At, 1, 0); PG8_STAGE(PG8_SA(0, 1), a2 + hstepA, voffA);
      PG8_WAIT_LB; PG8_BAR; PG8_WAIT_L(0); PG8_MMA(0, 0, At, B0); PG8_BAR; PG8_SCHED;
      PG8_LDB(B1, 1, 1); PG8_STAGE(PG8_SB(1, 0), b3, voffB);
      PG8_BAR; PG8_WAIT_L(0); PG8_MMA(0, 1, At, B1); PG8_BAR;
      PG8_LDA(At, 1, 1); PG8_STAGE(PG8_SA(1, 0), a3, voffA);
      PG8_BAR; PG8_WAIT_L(0); PG8_MMA(1, 0, At, B0); PG8_BAR; PG8_SCHED;
      PG8_STAGE(PG8_SB(1, 1), b3 + hstepB, voffB);
      PG8_WAIT_V(6); PG8_BAR; PG8_MMA(1, 1, At, B1); PG8_BAR;
    }
    if constexpr (!Epi::AFTER_DRAIN) E(acc, cur, wr, wc, fr, fq);
    if (!has_next) break;
#pragma unroll
    for (int a = 0; a < 2; ++a)
#pragma unroll
      for (int b = 0; b < 2; ++b)
#pragma unroll
        for (int m = 0; m < 4; ++m)
#pragma unroll
          for (int n = 0; n < 2; ++n) acc[a][b][m][n] = (f32x4){0.f, 0.f, 0.f, 0.f};
    cur = nxt; cA = nA; cB = nB; ++ui;
  }
  PG8_WAIT_V(0);
  if (wr == 0) PG8_BAR;
  PG8_BAR;
  if constexpr (Epi::AFTER_DRAIN) E(acc, cur, wr, wc, fr, fq);
#undef PG8_SA
#undef PG8_SB
#undef PG8_STAGE
#undef PG8_LDA
#undef PG8_LDB
#undef PG8_MMA
#undef PG8_WAIT_V
#undef PG8_WAIT_L
#undef PG8_WAIT_LB
#undef PG8_BAR
#undef PG8_SCHED
}

__device__ __forceinline__ void phase_conv(const Params& p) {
  const u16* ZA = (const u16*)(p.ws + OFF_ZA);
  u16* RC = (u16*)(p.ws + OFF_H);
  u16* KC = (u16*)(p.ws + OFF_KC);
  u16* VC = (u16*)(p.ws + OFF_VC);
  u16* WA = (u16*)(p.ws + OFF_WA);
  float* RN = (float*)(p.ws + OFF_RN);
  float* BD = (float*)(p.ws + OFF_BD);
  const int gt = blockIdx.x * NTHR + threadIdx.x, gs = gridDim.x * NTHR;
  {
    const int hi = gt & 127, h = hi >> 3, i = hi & 7;
    const int cbase = h * 64 + i * 8;
    float kkw[8], rkw[8];
#pragma unroll
    for (int e = 0; e < 8; ++e) { kkw[e] = p.k_k[cbase + e]; rkw[e] = p.r_k[cbase + e]; }
    float cw3[3][3][8];
#pragma unroll
    for (int sa = 0; sa < 3; ++sa)
#pragma unroll
      for (int tp = 0; tp < 3; ++tp)
#pragma unroll
        for (int e = 0; e < 8; ++e) cw3[sa][tp][e] = p.conv_a[tp * ZAW + sa * 1024 + cbase + e];
    for (int u = gt; u < (NTOK / 4) * 128; u += gs) {
      const int tok0 = (u >> 7) * 4;
      int t0, T;
      if (tok0 < NCTX) { t0 = tok0 & 255; T = 256; } else { t0 = (tok0 - NCTX) & 1023; T = 1024; }
      float res[3][4][8];
#pragma unroll
      for (int sa = 0; sa < 3; ++sa) {
        const int col = sa * 1024 + cbase;
        const bf16x8 z = {0, 0, 0, 0, 0, 0, 0, 0};
        bf16x8 rw[6];
#pragma unroll
        for (int q = 0; q < 6; ++q) {
          const bool ok = (q == 0) ? (t0 > 0) : ((q == 5) ? (t0 + 4 < T) : true);
          rw[q] = ok ? *(const bf16x8*)(ZA + (size_t)(tok0 - 1 + q) * ZAW + col) : z;
        }
#pragma unroll
        for (int i4 = 0; i4 < 4; ++i4)
#pragma unroll
          for (int e = 0; e < 8; ++e)
            res[sa][i4][e] = cw3[sa][0][e] * bf2f((u16)rw[i4][e]) + cw3[sa][1][e] * bf2f((u16)rw[i4 + 1][e]) + cw3[sa][2][e] * bf2f((u16)rw[i4 + 2][e]);
      }
#pragma unroll
      for (int i4 = 0; i4 < 4; ++i4) {
        const int tok = tok0 + i4;
        u32x4 o;
        o.x = cvt_pk_bf16(res[0][i4][0], res[0][i4][1]); o.y = cvt_pk_bf16(res[0][i4][2], res[0][i4][3]); o.z = cvt_pk_bf16(res[0][i4][4], res[0][i4][5]); o.w = cvt_pk_bf16(res[0][i4][6], res[0][i4][7]);
        *(u32x4*)(RC + (size_t)tok * 1024 + cbase) = o;
        o.x = cvt_pk_bf16(res[1][i4][0], res[1][i4][1]); o.y = cvt_pk_bf16(res[1][i4][2], res[1][i4][3]); o.z = cvt_pk_bf16(res[1][i4][4], res[1][i4][5]); o.w = cvt_pk_bf16(res[1][i4][6], res[1][i4][7]);
        *(u32x4*)(KC + (size_t)tok * 1024 + cbase) = o;
        o.x = cvt_pk_bf16(res[2][i4][0], res[2][i4][1]); o.y = cvt_pk_bf16(res[2][i4][2], res[2][i4][3]); o.z = cvt_pk_bf16(res[2][i4][4], res[2][i4][5]); o.w = cvt_pk_bf16(res[2][i4][6], res[2][i4][7]);
        *(u32x4*)(VC + (size_t)tok * 1024 + cbase) = o;
        float ss = 0, bd = 0;
#pragma unroll
        for (int e = 0; e < 8; ++e) {
          float kk = res[1][i4][e] * kkw[e];
          ss += kk * kk;
          bd += res[0][i4][e] * res[1][i4][e] * rkw[e];
        }
        ss = red8(ss);
        bd = red8(bd);
        if (i == 0) {
          RN[tok * 16 + h] = rsqrtf(fmaxf(ss, 1e-12f));
          BD[tok * 16 + h] = bd;
        }
      }
    }
  }
  for (int u = gt; u < NTOK * 16; u += gs) {
    const int tok = u >> 4, jv = u & 15;
    int t, T;
    if (tok < NCTX) { t = tok & 255; T = 256; } else { t = (tok - NCTX) & 1023; T = 1024; }
    const int col = 3072 + jv * 8;
    bf16x8 z = {0, 0, 0, 0, 0, 0, 0, 0};
    bf16x8 c1 = *(const bf16x8*)(ZA + (size_t)tok * ZAW + col);
    bf16x8 c0 = (t > 0) ? *(const bf16x8*)(ZA + (size_t)(tok - 1) * ZAW + col) : z;
    bf16x8 c2 = (t < T - 1) ? *(const bf16x8*)(ZA + (size_t)(tok + 1) * ZAW + col) : z;
    bf16x8 o;
#pragma unroll
    for (int e = 0; e < 8; ++e) {
      float w0 = p.conv_a[col + e], w1 = p.conv_a[ZAW + col + e], w2 = p.conv_a[2 * ZAW + col + e];
      float r = w0 * bf2f((u16)c0[e]) + w1 * bf2f((u16)c1[e]) + w2 * bf2f((u16)c2[e]);
      if (jv < 8) r = tanhf(r);
      o[e] = (short)f2bf(r);
    }
    *(bf16x8*)(WA + (size_t)tok * 128 + jv * 8) = o;
  }
  {
    const float* rcos = (const float*)(p.ws + OFF_ROPE);
    const float* rsin = rcos + 1024;
    const u16* KL = (const u16*)(p.ws + OFF_KL);
    for (int u = gt; u < 425984; u += gs) {
      bf16x8 o;
      if (u < 294912) {
        const bool isc = u < 262144;
        const int v = isc ? u : u - 262144;
        const float* src = (isc ? p.out + OUT_NEWK : p.cache_k) + (size_t)v * 8;
        const float4 a = *(const float4*)src, b4 = *(const float4*)(src + 4);
        u32x4 w; w.x = cvt_pk_bf16(a.x, a.y); w.y = cvt_pk_bf16(a.z, a.w); w.z = cvt_pk_bf16(b4.x, b4.y); w.w = cvt_pk_bf16(b4.z, b4.w);
        *(u32x4*)((u16*)(p.ws + (isc ? OFF_KBC : OFF_KBK)) + (size_t)v * 8) = w;
      } else {
        const int v = u - 294912, d8 = (v & 7) * 8, row = v >> 3;
        const int t = row & 1023, bh = row >> 10, b = bh >> 2, hk = bh & 3;
        const size_t rowo = ((size_t)b * 1024 + t) * 256 + hk * 64;
        const bf16x8 x = *(const bf16x8*)(KL + rowo + d8);
        const bf16x8 xp = *(const bf16x8*)(KL + rowo + (d8 ^ 16));
        const int pos = (d8 >= 32) ? (t & 63) : (t >> 6);
        const bool lo = (d8 & 16) == 0;
#pragma unroll
        for (int e = 0; e < 8; ++e) {
          const int i = (d8 & 8) + e;
          const float cs = rcos[pos * 16 + i], sn = rsin[pos * 16 + i];
          const float a = bf2f((u16)x[e]), bpart = bf2f((u16)xp[e]);
          o[e] = (short)f2bf(lo ? (a * cs - bpart * sn) : (bpart * sn + a * cs));
        }
        *(bf16x8*)((u16*)(p.ws + OFF_KBL) + (size_t)row * 64 + d8) = o;
      }
    }
    const u16* VL = (const u16*)(p.ws + OFF_VL);
    float* sm = (float*)smem_raw;
    const int tid = threadIdx.x;
    for (int it = blockIdx.x; it < 832; it += gridDim.x) {
      const int key = tid >> 3, d8 = (tid & 7) * 8;
      float f[8];
      u16* dst;
      int Tk, t0;
      if (it < 576) {
        const bool isc = it < 512;
        const int v = isc ? it : it - 512, bh = v >> 2;
        t0 = (v & 3) * 64; Tk = 256;
        const float* src = (isc ? p.out + OUT_NEWV : p.cache_v) + ((size_t)bh * 256 + t0 + key) * 64 + d8;
        const float4 a = *(const float4*)src, b4 = *(const float4*)(src + 4);
        f[0] = a.x; f[1] = a.y; f[2] = a.z; f[3] = a.w; f[4] = b4.x; f[5] = b4.y; f[6] = b4.z; f[7] = b4.w;
        dst = (u16*)(p.ws + (isc ? OFF_VTC : OFF_VTK)) + (size_t)bh * 64 * 256;
      } else {
        const int v = it - 576, bh = v >> 4, b = bh >> 2, hk = bh & 3;
        t0 = (v & 15) * 64; Tk = 1024;
        const bf16x8 x = *(const bf16x8*)(VL + ((size_t)b * 1024 + t0 + key) * 256 + hk * 64 + d8);
#pragma unroll
        for (int e = 0; e < 8; ++e) f[e] = bf2f((u16)x[e]);
        dst = (u16*)(p.ws + OFF_VTL) + (size_t)bh * 64 * 1024;
      }
#pragma unroll
      for (int e = 0; e < 8; ++e) sm[key * 65 + d8 + e] = f[e];
      __syncthreads();
      {
        const int d = tid >> 3, k8 = (tid & 7) * 8;
        u32x4 w;
        w.x = cvt_pk_bf16(sm[(k8 + 0) * 65 + d], sm[(k8 + 1) * 65 + d]); w.y = cvt_pk_bf16(sm[(k8 + 2) * 65 + d], sm[(k8 + 3) * 65 + d]);
        w.z = cvt_pk_bf16(sm[(k8 + 4) * 65 + d], sm[(k8 + 5) * 65 + d]); w.w = cvt_pk_bf16(sm[(k8 + 6) * 65 + d], sm[(k8 + 7) * 65 + d]);
        *(u32x4*)(dst + (size_t)d * Tk + t0 + k8) = w;
      }
      __syncthreads();
    }
  }
}


constexpr int S3_AH = 0, S3_RH = 2304, S3_VT = 4608, S3_BKT = 7680, S3_D15 = 12800, SET3_B = 13056;
constexpr int S2_BH = 0, S2_KH = 2304, SET2_B = 4608;
constexpr int G_ABF = 0, G_ABO = 256, G_AKH = 1024, G_RBH = 1792, G_RKH = 2560, GRAM_B = 3584;
constexpr int O_SET3 = 0, O_SET2 = 3 * SET3_B, O_GRAM = O_SET2 + 2 * SET2_B, O_YB = O_GRAM + 2 * GRAM_B;
constexpr int CH_BYTES = O_YB + 2 * 4096;
static_assert(2 * CH_BYTES <= 131072, "scan LDS overflow");

__device__ __forceinline__ bf16x8 pack8(uint2 lo, uint2 hi) {
  u32x4 t = {lo.x, lo.y, hi.x, hi.y};
  return __builtin_bit_cast(bf16x8, t);
}
#define LDSBAR() do { asm volatile("s_waitcnt lgkmcnt(0)" ::: "memory"); __builtin_amdgcn_s_barrier(); asm volatile("" ::: "memory"); } while (0)

struct ScanK {
  const u16 *RC, *KC, *VC, *WA;
  const float* RN;
  unsigned oWA, oRC, oRN;
  u16* Y;
  const u16* Yo;
  const float* BD;
  u16* GA;
  int d, cw, fr, fq, kcol, ch, h, ctid;
  float w0v, a0v, kkc, kac;
  float lw[4], lb[4];
};
struct ScanPre { bf16x8 paw[2], paa[2]; u16 prc[4], pkc[4], pvc[4]; float prn[4]; };

template <int D>
__device__ __forceinline__ void scan_load(ScanK& k, ScanPre& r) {
#pragma unroll
  for (int ks = 0; ks < 2; ++ks) {
    r.paw[ks] = *(const bf16x8*)(k.WA + k.oWA + ks * 32);
    r.paa[ks] = *(const bf16x8*)(k.WA + k.oWA + 64 + ks * 32);
  }
#pragma unroll
  for (int j = 0; j < 4; ++j) {
    r.prc[j] = k.RC[k.oRC + j * 1024]; r.pkc[j] = k.KC[k.oRC + j * 1024]; r.pvc[j] = k.VC[k.oRC + j * 1024];
    r.prn[j] = k.RN[k.oRN + j * 16];
  }
  if (D) { k.oWA -= 16 * 128; k.oRC -= 16 * 1024; k.oRN -= 16 * 16; }
  else { k.oWA += 16 * 128; k.oRC += 16 * 1024; k.oRN += 16 * 16; }
}

template <int D>
__device__ __forceinline__ void scan_s0(const ScanK& k, const ScanPre& r, const bf16x8 (&bw)[2], const bf16x8 (&ba)[2], char* set3, char* set2) {
  u16* AH = (u16*)(set3 + S3_AH); u16* RH = (u16*)(set3 + S3_RH); u16* VT = (u16*)(set3 + S3_VT); u16* BKT = (u16*)(set3 + S3_BKT);
  float* D15 = (float*)(set3 + S3_D15);
  u16* BH = (u16*)(set2 + S2_BH); u16* KH = (u16*)(set2 + S2_KH);
  constexpr int d = D;
  const int fq = k.fq, fr = k.fr, kcol = k.kcol;
  f32x4 accw = {0, 0, 0, 0}, acca = {0, 0, 0, 0};
#pragma unroll
  for (int ks = 0; ks < 2; ++ks) {
    accw = __builtin_amdgcn_mfma_f32_16x16x32_bf16(r.paw[ks], bw[ks], accw, 0, 0, 0);
    acca = __builtin_amdgcn_mfma_f32_16x16x32_bf16(r.paa[ks], ba[ks], acca, 0, 0, 0);
  }
  float fa[4], fb[4], fk[4], frr[4], fw[4], fv[4];
#pragma unroll
  for (int j = 0; j < 4; ++j) {
    const float rc = bf2f(r.prc[j]), kc = bf2f(r.pkc[j]);
    fv[j] = bf2f(r.pvc[j]);
    const float e = 0.60653066f * sigmoidf_(k.w0v + accw[j]);
    fw[j] = __expf(-e);
    const float av = sigmoidf_(k.a0v + acca[j]);
    const float kkv = kc * k.kkc * r.prn[j];
    fa[j] = -kkv; fb[j] = kkv * av; fk[j] = kc * (1.f + (av - 1.f) * k.kac); frr[j] = rc;
  }
  float ER[4], EA[4];
  if (d == 0) { ER[0] = fw[0]; ER[1] = ER[0] * fw[1]; ER[2] = ER[1] * fw[2]; ER[3] = ER[2] * fw[3]; }
  else { ER[3] = fw[3]; ER[2] = ER[3] * fw[2]; ER[1] = ER[2] * fw[1]; ER[0] = ER[1] * fw[0]; }
  const float tot = d ? ER[0] : ER[3];
  const float g0 = __shfl(tot, fr), g1 = __shfl(tot, fr + 16), g2 = __shfl(tot, fr + 32), g3 = __shfl(tot, fr + 48);
  const float D15v = (g0 * g1) * (g2 * g3);
  float off;
  if (d == 0) off = (fq > 0 ? g0 : 1.f) * (fq > 1 ? g1 : 1.f) * (fq > 2 ? g2 : 1.f);
  else off = (fq < 3 ? g3 : 1.f) * (fq < 2 ? g2 : 1.f) * (fq < 1 ? g1 : 1.f);
#pragma unroll
  for (int j = 0; j < 4; ++j) ER[j] *= off;
  if (d == 0) { EA[0] = off; EA[1] = ER[0]; EA[2] = ER[1]; EA[3] = ER[2]; }
  else { EA[3] = off; EA[2] = ER[3]; EA[1] = ER[2]; EA[0] = ER[1]; }
  float btv[4], ktv[4];
#pragma unroll
  for (int j = 0; j < 4; ++j) {
    const int tkn = fq * 4 + j, jj = d ? 15 - tkn : tkn;
    const float inv = __builtin_amdgcn_rcpf(ER[j]), EE = inv * D15v;
    const unsigned p1 = cvt_pk_bf16(fa[j] * EA[j], frr[j] * ER[j]);
    const unsigned p2 = cvt_pk_bf16(fb[j] * inv, fk[j] * inv);
    AH[jj * 72 + kcol] = (u16)(p1 & 0xffffu);
    RH[jj * 72 + kcol] = (u16)(p1 >> 16);
    BH[jj * 72 + kcol] = (u16)(p2 & 0xffffu);
    KH[jj * 72 + kcol] = (u16)(p2 >> 16);
    btv[j] = fb[j] * EE;
    ktv[j] = fk[j] * EE;
  }
  const int jj0 = d ? 12 - fq * 4 : fq * 4;
  uint2 pb, pk, pv;
  if (d == 0) {
    pb.x = cvt_pk_bf16(btv[0], btv[1]); pb.y = cvt_pk_bf16(btv[2], btv[3]);
    pk.x = cvt_pk_bf16(ktv[0], ktv[1]); pk.y = cvt_pk_bf16(ktv[2], ktv[3]);
    pv.x = cvt_pk_bf16(fv[0], fv[1]); pv.y = cvt_pk_bf16(fv[2], fv[3]);
  } else {
    pb.x = cvt_pk_bf16(btv[3], btv[2]); pb.y = cvt_pk_bf16(btv[1], btv[0]);
    pk.x = cvt_pk_bf16(ktv[3], ktv[2]); pk.y = cvt_pk_bf16(ktv[1], ktv[0]);
    pv.x = cvt_pk_bf16(fv[3], fv[2]); pv.y = cvt_pk_bf16(fv[1], fv[0]);
  }
  *(uint2*)(BKT + kcol * 40 + jj0) = pb;
  *(uint2*)(BKT + kcol * 40 + 16 + jj0) = pk;
  *(uint2*)(VT + kcol * 24 + jj0) = pv;
  if (fq == 0) D15[kcol] = D15v;
}

__device__ __forceinline__ void scan_s3(const ScanK& k, const char* set3, const char* set2, char* gram) {
  const int cw = k.cw, fr = k.fr, fq = k.fq;
  const u16* Asrc = (const u16*)(set3 + ((cw < 2) ? S3_AH : S3_RH));
  const u16* Bsrc = (const u16*)(set2 + ((cw & 1) ? S2_KH : S2_BH));
  float* ABF = (float*)(gram + G_ABF);
  u16* ABO = (u16*)(gram + G_ABO); u16* AKH = (u16*)(gram + G_AKH); u16* RBH = (u16*)(gram + G_RBH); u16* RKH = (u16*)(gram + G_RKH);
  f32x4 g = {0, 0, 0, 0};
#pragma unroll
  for (int ks = 0; ks < 2; ++ks) {
    bf16x8 af = *(const bf16x8*)(Asrc + fr * 72 + ks * 32 + fq * 8);
    bf16x8 bf_ = *(const bf16x8*)(Bsrc + fr * 72 + ks * 32 + fq * 8);
    g = __builtin_amdgcn_mfma_f32_16x16x32_bf16(af, bf_, g, 0, 0, 0);
  }
  u16* dstw = ABO + cw * 384;
  const int incl = cw >> 1;
  const bool samebk = (cw == 0) && ((fr >> 2) == fq);
#pragma unroll
  for (int j = 0; j < 4; ++j) {
    const int jrow = fq * 4 + j;
    const float val = (fr < jrow + incl) ? g[j] : 0.f;
    dstw[jrow * 24 + fr] = samebk ? (u16)0 : f2bf(val);
    if (samebk) ABF[jrow * 4 + (fr & 3)] = val;
  }
  (void)AKH; (void)RBH; (void)RKH;
}

template <int D>
__device__ __forceinline__ void scan_s5(const ScanK& k, f32x4 (&Zt)[4], const char* set3, const char* gram, float* YB) {
  const u16* AH = (const u16*)(set3 + S3_AH); const u16* RH = (const u16*)(set3 + S3_RH); const u16* VT = (const u16*)(set3 + S3_VT);
  const u16* BKT = (const u16*)(set3 + S3_BKT); const float* D15 = (const float*)(set3 + S3_D15);
  const float* ABF = (const float*)(gram + G_ABF);
  const u16* ABO = (const u16*)(gram + G_ABO); const u16* AKH = (const u16*)(gram + G_AKH); const u16* RBH = (const u16*)(gram + G_RBH); const u16* RKH = (const u16*)(gram + G_RKH);
  constexpr int d = D;
  const int fr = k.fr, fq = k.fq, kcol = k.kcol;
  const uint2 z2 = make_uint2(0u, 0u);
  bf16x8 zb[2];
#pragma unroll
  for (int ks = 0; ks < 2; ++ks) {
    uint2 lo, hi;
    lo.x = cvt_pk_bf16(Zt[2 * ks][0], Zt[2 * ks][1]); lo.y = cvt_pk_bf16(Zt[2 * ks][2], Zt[2 * ks][3]);
    hi.x = cvt_pk_bf16(Zt[2 * ks + 1][0], Zt[2 * ks + 1][1]); hi.y = cvt_pk_bf16(Zt[2 * ks + 1][2], Zt[2 * ks + 1][3]);
    zb[ks] = pack8(lo, hi);
  }
  f32x4 accX = {0, 0, 0, 0}, accY = {0, 0, 0, 0};
#pragma unroll
  for (int ks = 0; ks < 2; ++ks) {
    bf16x8 aA = pack8(*(const uint2*)(AH + fr * 72 + (2 * ks) * 16 + fq * 4), *(const uint2*)(AH + fr * 72 + (2 * ks + 1) * 16 + fq * 4));
    bf16x8 aR = pack8(*(const uint2*)(RH + fr * 72 + (2 * ks) * 16 + fq * 4), *(const uint2*)(RH + fr * 72 + (2 * ks + 1) * 16 + fq * 4));
    accX = __builtin_amdgcn_mfma_f32_16x16x32_bf16(aA, zb[ks], accX, 0, 0, 0);
    accY = __builtin_amdgcn_mfma_f32_16x16x32_bf16(aR, zb[ks], accY, 0, 0, 0);
  }
  const uint2 vv8 = *(const uint2*)(VT + kcol * 24 + fq * 4);
  accX = __builtin_amdgcn_mfma_f32_16x16x16bf16_1k(__builtin_bit_cast(bf16x4, *(const uint2*)(AKH + fr * 24 + fq * 4)), __builtin_bit_cast(bf16x4, vv8), accX, 0, 0, 0);
  uint2 s2 = z2;
  {
    const float4 d1 = *(const float4*)(ABF + (fq * 4 + 1) * 4), d2 = *(const float4*)(ABF + (fq * 4 + 2) * 4), d3 = *(const float4*)(ABF + (fq * 4 + 3) * 4);
    const bf16x4 aAb = __builtin_bit_cast(bf16x4, *(const uint2*)(ABO + fr * 24 + fq * 4));
    const float T10 = d1.x, T21 = d2.y, T32 = d3.z;
    const float T20 = d2.x + d2.y * d1.x;
    const float T31 = d3.y + d3.z * d2.y;
    const float T30 = d3.x + d3.y * d1.x + d3.z * T20;
    f32x4 accS = accX;
#pragma unroll
    for (int q = 0; q < 4; ++q) {
      const float t0 = accS[0];
      const float t1 = accS[1] + T10 * t0;
      const float t2 = accS[2] + T20 * t0 + T21 * accS[1];
      const float t3 = accS[3] + T30 * t0 + T31 * accS[1] + T32 * accS[2];
      uint2 pk;
      pk.x = cvt_pk_bf16(t0, t1); pk.y = cvt_pk_bf16(t2, t3);
      if (fq == q) s2 = pk;
      if (q < 3) {
        const uint2 m = (fq == q) ? pk : z2;
        accS = __builtin_amdgcn_mfma_f32_16x16x16bf16_1k(aAb, __builtin_bit_cast(bf16x4, m), accS, 0, 0, 0);
      }
    }
  }
  const bf16x8 sb = pack8(s2, vv8);
  accY = __builtin_amdgcn_mfma_f32_16x16x32_bf16(pack8(*(const uint2*)(RBH + fr * 24 + fq * 4), *(const uint2*)(RKH + fr * 24 + fq * 4)), sb, accY, 0, 0, 0);
#pragma unroll
  for (int j = 0; j < 4; ++j) {
    const int jrow = fq * 4 + j, tkn = d ? 15 - jrow : jrow;
    YB[tkn * 64 + kcol] = accY[j];
  }
#pragma unroll
  for (int kt = 0; kt < 4; ++kt) {
    const float4 dd = *(const float4*)(D15 + kt * 16 + fq * 4);
    f32x4 z = Zt[kt];
    z[0] *= dd.x; z[1] *= dd.y; z[2] *= dd.z; z[3] *= dd.w;
    const u16* bk = BKT + (kt * 16 + fr) * 40 + fq * 4;
    Zt[kt] = __builtin_amdgcn_mfma_f32_16x16x32_bf16(pack8(*(const uint2*)bk, *(const uint2*)(bk + 16)), sb, z, 0, 0, 0);
  }
}

struct FlushPre { uint2 yo, vc, ga; float bd; };
__device__ __forceinline__ void scan_flush_load(const ScanK& k, FlushPre& f, int tb) {
  const int tkn = k.ctid >> 4, k4 = (k.ctid & 15) * 4;
  const size_t tok = (size_t)(tb + tkn);
  f.yo = *(const uint2*)(k.Yo + tok * 1024 + k.h * 64 + k4);
  f.vc = *(const uint2*)(k.VC + tok * 1024 + k.h * 64 + k4);
  f.ga = *(const uint2*)(k.GA + tok * 2048 + k.h * 64 + k4);
  f.bd = k.BD[tok * 16 + k.h];
}
__device__ __forceinline__ void scan_flush_fin(const ScanK& k, const FlushPre& f, const float* YB, int tb, bool second) {
  const int tkn = k.ctid >> 4, k4 = (k.ctid & 15) * 4;
  const float4 yv = *(const float4*)(YB + tkn * 64 + k4);
  const size_t tok = (size_t)(tb + tkn);
  if (!second) {
    uint2 o;
    o.x = cvt_pk_bf16(yv.x, yv.y);
    o.y = cvt_pk_bf16(yv.z, yv.w);
    *(uint2*)(k.Y + tok * 1024 + k.h * 64 + k4) = o;
  } else {
    const uint2 yo = f.yo, vc = f.vc, ga = f.ga;
    const float bd = f.bd;
    const float y0 = yv.x + bflo(yo.x), y1 = yv.y + bfhi(yo.x), y2 = yv.z + bflo(yo.y), y3 = yv.w + bfhi(yo.y);
    const float s1 = red16(y0 + y1 + y2 + y3);
    const float s2 = red16(y0 * y0 + y1 * y1 + y2 * y2 + y3 * y3);
    const float mu = s1 * (1.f / 64.f);
    const float var = fmaxf(s2 * (1.f / 64.f) - mu * mu, 0.f);
    const float rstd = rsqrtf(var + 64e-5f);
    const float o0 = ((y0 - mu) * rstd * k.lw[0] + k.lb[0] + bd * bflo(vc.x)) * bflo(ga.x);
    const float o1 = ((y1 - mu) * rstd * k.lw[1] + k.lb[1] + bd * bfhi(vc.x)) * bfhi(ga.x);
    const float o2 = ((y2 - mu) * rstd * k.lw[2] + k.lb[2] + bd * bflo(vc.y)) * bflo(ga.y);
    const float o3 = ((y3 - mu) * rstd * k.lw[3] + k.lb[3] + bd * bfhi(vc.y)) * bfhi(ga.y);
    uint2 o;
    o.x = cvt_pk_bf16(o0, o1);
    o.y = cvt_pk_bf16(o2, o3);
    *(uint2*)(k.GA + tok * 2048 + k.h * 64 + k4) = o;
  }
}
__device__ __forceinline__ void scan_flush(const ScanK& k, const float* YB, int tb, bool second) {
  FlushPre f;
  f.yo = make_uint2(0u, 0u); f.vc = f.yo; f.ga = f.yo; f.bd = 0.f;
  if (second) scan_flush_load(k, f, tb);
  scan_flush_fin(k, f, YB, tb, second);
}

template <int D>
__device__ __forceinline__ void scan_chain(const Params& p, bool latent, int idx, int tid) {
  const int lane = tid & 63;
  const int b = idx >> 4;
  ScanK k;
  k.d = D; k.ctid = tid & 255; k.cw = __builtin_amdgcn_readfirstlane((tid >> 6) & 3); k.fr = lane & 15; k.fq = lane >> 4; k.h = idx & 15;
  k.kcol = 16 * k.cw + k.fr; k.ch = k.h * 64 + k.kcol;
  constexpr int d = D;
  const int ch = k.ch;
  const int T = latent ? 1024 : 256;
  const int tok0 = latent ? NCTX + b * 1024 : b * 256;
  char* cs = smem_raw + d * CH_BYTES;
  k.RC = (const u16*)(p.ws + OFF_H); k.KC = (const u16*)(p.ws + OFF_KC); k.VC = (const u16*)(p.ws + OFF_VC);
  k.WA = (const u16*)(p.ws + OFF_WA); k.RN = (const float*)(p.ws + OFF_RN);
  {
    const int tb0 = tok0 + (D ? (T >> 4) - 1 : 0) * 16;
    k.oWA = (unsigned)((tb0 + k.fr) * 128 + k.fq * 8);
    k.oRC = (unsigned)((tb0 + k.fq * 4) * 1024 + ch);
    k.oRN = (unsigned)((tb0 + k.fq * 4) * 16 + k.h);
  }
  k.Y = (u16*)(p.ws + OFF_ZA + (size_t)d * SZ_ACT);
  k.Yo = (const u16*)(p.ws + OFF_ZA + (size_t)(1 - d) * SZ_ACT);
  k.BD = (const float*)(p.ws + OFF_BD);
  k.GA = (u16*)(p.ws + OFF_AQ);
#pragma unroll
  for (int e = 0; e < 4; ++e) { k.lw[e] = p.ln_w[k.h * 64 + (k.ctid & 15) * 4 + e]; k.lb[e] = p.ln_b[k.h * 64 + (k.ctid & 15) * 4 + e]; }
  k.w0v = p.w0[d * 1024 + ch]; k.a0v = p.a0[d * 1024 + ch]; k.kkc = p.k_k[ch]; k.kac = p.k_a[ch];
  bf16x8 bw[2], ba[2];
#pragma unroll
  for (int ks = 0; ks < 2; ++ks)
#pragma unroll
    for (int e = 0; e < 8; ++e) {
      int l = ks * 32 + k.fq * 8 + e;
      bw[ks][e] = (short)f2bf(p.w_up[(size_t)(d * 64 + l) * 1024 + ch]);
      ba[ks][e] = (short)f2bf(p.a_up[(size_t)(d * 64 + l) * 1024 + ch]);
    }
  f32x4 Zt[4];
  if (latent) {
    const float* s0 = p.state + ((size_t)(b * 2 + d) * 16 + k.h) * 4096 + k.kcol * 64 + k.fq * 4;
#pragma unroll
    for (int kt = 0; kt < 4; ++kt) Zt[kt] = *(const f32x4*)(s0 + kt * 16);
  } else {
#pragma unroll
    for (int kt = 0; kt < 4; ++kt) Zt[kt] = (f32x4){0.f, 0.f, 0.f, 0.f};
  }
  const int nc = T >> 4;
#define TB(c) (tok0 + (d ? nc - 1 - (c) : (c)) * 16)
#define SET3(c) (cs + O_SET3 + ((c) % 3) * SET3_B)
#define SET2(c) (cs + O_SET2 + ((c) & 1) * SET2_B)
#define GRAM(c) (cs + O_GRAM + ((c) & 1) * GRAM_B)
#define YBUF(c) ((float*)(cs + O_YB + ((c) & 1) * 4096))
  ScanPre r;
  scan_load<D>(k, r);
  scan_s0<D>(k, r, bw, ba, SET3(0), SET2(0));
  scan_load<D>(k, r);
  LDSBAR();
  scan_s3(k, SET3(0), SET2(0), GRAM(0));
  scan_s0<D>(k, r, bw, ba, SET3(1), SET2(1));
  scan_load<D>(k, r);
  LDSBAR();
  const int hc = nc >> 1;
  int m3 = 0;
  for (int i = 0; i < nc - 2; ++i) {
    const int m3b = (m3 == 2) ? 0 : m3 + 1, m3c = (m3b == 2) ? 0 : m3b + 1;
    FlushPre fpre;
    fpre.yo = make_uint2(0u, 0u); fpre.vc = fpre.yo; fpre.ga = fpre.yo; fpre.bd = 0.f;
    const bool fsec = (i - 1) >= hc;
    if (i > 0 && fsec) scan_flush_load(k, fpre, TB(i - 1));
    scan_s5<D>(k, Zt, cs + O_SET3 + m3 * SET3_B, GRAM(i), YBUF(i));
    scan_s3(k, cs + O_SET3 + m3b * SET3_B, SET2(i + 1), GRAM(i + 1));
    scan_s0<D>(k, r, bw, ba, cs + O_SET3 + m3c * SET3_B, SET2(i));
    if (i + 3 < nc) scan_load<D>(k, r);
    if (i > 0) scan_flush_fin(k, fpre, YBUF(i - 1), TB(i - 1), fsec);
    if (i == hc) asm volatile("s_waitcnt vmcnt(0)" ::: "memory");
    LDSBAR();
    m3 = m3b;
  }
  {
    const int i = nc - 2;
    FlushPre fpre;
    scan_flush_load(k, fpre, TB(i - 1));
    scan_s5<D>(k, Zt, SET3(i), GRAM(i), YBUF(i));
    scan_s3(k, SET3(i + 1), SET2(i + 1), GRAM(i + 1));
    scan_flush_fin(k, fpre, YBUF(i - 1), TB(i - 1), true);
    LDSBAR();
  }
  {
    const int i = nc - 1;
    FlushPre fpre;
    scan_flush_load(k, fpre, TB(i - 1));
    scan_s5<D>(k, Zt, SET3(i), GRAM(i), YBUF(i));
    scan_flush_fin(k, fpre, YBUF(i - 1), TB(i - 1), true);
    LDSBAR();
    scan_flush(k, YBUF(i), TB(i), true);
  }
#undef TB
#undef SET3
#undef SET2
#undef GRAM
#undef YBUF
  if (!latent) {
    float* so = p.out + OUT_STATE + ((size_t)(b * 2 + d) * 16 + k.h) * 4096 + k.kcol * 64 + k.fq * 4;
#pragma unroll
    for (int kt = 0; kt < 4; ++kt) *(f32x4*)(so + kt * 16) = Zt[kt];
  }
  __syncthreads();
}

__device__ __forceinline__ void scan_item(const Params& p, bool latent, int idx) {
  int tid = threadIdx.x;
  asm volatile("" : "+v"(tid));
  if (__builtin_amdgcn_readfirstlane(tid >> 8)) scan_chain<1>(p, latent, idx, tid);
  else scan_chain<0>(p, latent, idx, tid);
  __syncthreads();
}

constexpr int KST = 72;
constexpr int ATT_BUF = 2 * 64 * KST * 2;

__device__ __forceinline__ void attn_item(const Params& p, bool latent, int idx) {
  int tid = threadIdx.x;
  asm volatile("" : "+v"(tid));
  const int w = __builtin_amdgcn_readfirstlane(tid >> 6), lane = tid & 63, fr = lane & 15, fq = lane >> 4;
  int b, head, qb;
  if (latent) { b = idx >> 6; head = (idx >> 2) & 15; qb = idx & 3; }
  else { b = idx >> 4; head = idx & 15; qb = 0; }
  const int hk = head >> 2;
  u16* Q = (u16*)(p.ws + OFF_AQ) + 1024;
  const u16* GB = (const u16*)(p.ws + OFF_GB);
  const float* rcos = (const float*)(p.ws + OFF_ROPE);
  const float* rsin = rcos + 1024;
  int qpos[2];
  size_t qtok[2];
  bf16x8 qf[2][2];
#pragma unroll
  for (int qt = 0; qt < 2; ++qt) {
    qpos[qt] = qb * 256 + w * 32 + qt * 16 + fr;
    qtok[qt] = latent ? (size_t)NCTX + b * 1024 + qpos[qt] : (size_t)b * 256 + qpos[qt];
#pragma unroll
    for (int ks = 0; ks < 2; ++ks) {
      bf16x8 x = *(const bf16x8*)(Q + qtok[qt] * 2048 + head * 64 + ks * 32 + fq * 8);
      if (latent) {
        bf16x8 xp = *(const bf16x8*)(Q + qtok[qt] * 2048 + head * 64 + ks * 32 + (fq ^ 2) * 8);
        const int pos = ks ? (qpos[qt] & 63) : (qpos[qt] >> 6);
#pragma unroll
        for (int e = 0; e < 8; ++e) {
          int i = (fq & 1) * 8 + e;
          float cs = rcos[pos * 16 + i], sn = rsin[pos * 16 + i];
          float a = bf2f((u16)x[e]), bpart = bf2f((u16)xp[e]);
          float o = (fq < 2) ? (a * cs - bpart * sn) : (bpart * sn + a * cs);
          x[e] = (short)f2bf(o);
        }
      }
      qf[qt][ks] = x;
    }
  }
  float m_run[2], l_run[2];
  f32x4 ot[2][4];
#pragma unroll
  for (int qt = 0; qt < 2; ++qt) {
    m_run[qt] = p.sink[head]; l_run[qt] = 1.f;
#pragma unroll
    for (int dt = 0; dt < 4; ++dt) ot[qt][dt] = (f32x4){0, 0, 0, 0};
  }
  int lt0 = 0, nloc = 0;
  if (latent) {
    int ks0 = qb * 256 - 128; if (ks0 < 0) ks0 = 0;
    int ke = qb * 256 + 384; if (ke > 1024) ke = 1024;
    lt0 = ks0 >> 6; nloc = (ke >> 6) - lt0;
  }
  const int ntile = nloc + 4;
  const int wq_lo = qb * 256 + w * 32, wq_hi = wq_lo + 31;
  const u16* KBloc = (const u16*)(p.ws + OFF_KBL) + (size_t)(b * 4 + hk) * 1024 * 64;
  const u16* VTloc = (const u16*)(p.ws + OFF_VTL) + (size_t)(b * 4 + hk) * 64 * 1024;
  const u16* KBctx = (const u16*)(p.ws + (latent ? OFF_KBK : OFF_KBC)) + (size_t)(b * 4 + hk) * 256 * 64;
  const u16* VTctx = (const u16*)(p.ws + (latent ? OFF_VTK : OFF_VTC)) + (size_t)(b * 4 + hk) * 64 * 256;
  const int lrow = tid >> 3, lc8 = (tid & 7) * 8;
  bf16x8 kreg, vreg;
#define ATT_GLOAD(tt_)                                                                      \
  do {                                                                                      \
    if ((tt_) < nloc) {                                                                     \
      const int ks_ = (lt0 + (tt_)) * 64;                                                   \
      kreg = *(const bf16x8*)(KBloc + (size_t)(ks_ + lrow) * 64 + lc8);                     \
      vreg = *(const bf16x8*)(VTloc + (size_t)lrow * 1024 + ks_ + lc8);                     \
    } else {                                                                                \
      const int ks_ = ((tt_) - nloc) * 64;                                                  \
      kreg = *(const bf16x8*)(KBctx + (size_t)(ks_ + lrow) * 64 + lc8);                     \
      vreg = *(const bf16x8*)(VTctx + (size_t)lrow * 256 + ks_ + lc8);                      \
    }                                                                                       \
  } while (0)
#define ATT_LSTORE(buf_)                                                                    \
  do {                                                                                      \
    u16* ks__ = (u16*)(smem_raw + (buf_) * ATT_BUF);                                        \
    *(bf16x8*)(ks__ + lrow * KST + lc8) = kreg;                                             \
    *(bf16x8*)(ks__ + 64 * KST + lrow * KST + lc8) = vreg;                                  \
  } while (0)
  ATT_GLOAD(0);
  ATT_LSTORE(0);
  __syncthreads();
  for (int tt = 0; tt < ntile; ++tt) {
    const bool local = tt < nloc;
    const int kstart = local ? (lt0 + tt) * 64 : (tt - nloc) * 64;
    if (tt + 1 < ntile) ATT_GLOAD(tt + 1);
    const u16* Ks = (const u16*)(smem_raw + (tt & 1) * ATT_BUF);
    const u16* Vt = Ks + 64 * KST;
    const bool active = !local || !(kstart > wq_hi + 128 || kstart + 63 < wq_lo - 128);
    if (active) {
      f32x4 st[2][4];
#pragma unroll
      for (int mt = 0; mt < 4; ++mt) {
        f32x4 a0 = {0, 0, 0, 0}, a1 = {0, 0, 0, 0};
#pragma unroll
        for (int ks = 0; ks < 2; ++ks) {
          const bf16x8 kf = *(const bf16x8*)(Ks + (mt * 16 + fr) * KST + ks * 32 + fq * 8);
          a0 = __builtin_amdgcn_mfma_f32_16x16x32_bf16(kf, qf[0][ks], a0, 0, 0, 0);
          a1 = __builtin_amdgcn_mfma_f32_16x16x32_bf16(kf, qf[1][ks], a1, 0, 0, 0);
        }
        st[0][mt] = a0; st[1][mt] = a1;
      }
      bf16x8 pb[2][2];
#pragma unroll
      for (int qt = 0; qt < 2; ++qt) {
        if (local) {
#pragma unroll
          for (int mt = 0; mt < 4; ++mt)
#pragma unroll
            for (int j = 0; j < 4; ++j) {
              int kpos = kstart + mt * 16 + fq * 4 + j;
              int df = qpos[qt] - kpos;
              if (df > 128 || df < -128) st[qt][mt][j] = -1e30f;
            }
        }
        float mx = -1e30f;
#pragma unroll
        for (int mt = 0; mt < 4; ++mt)
#pragma unroll
          for (int j = 0; j < 4; ++j) mx = fmaxf(mx, st[qt][mt][j]);
        mx = fmaxf(mx, __shfl_xor(mx, 16));
        mx = fmaxf(mx, __shfl_xor(mx, 32));
        const float m_new = fmaxf(m_run[qt], mx);
        const float alpha = __expf(m_run[qt] - m_new);
        float rs = 0;
#pragma unroll
        for (int mt = 0; mt < 4; ++mt)
#pragma unroll
          for (int j = 0; j < 4; ++j) {
            float pv = __expf(st[qt][mt][j] - m_new);
            st[qt][mt][j] = pv;
            rs += pv;
          }
        rs += __shfl_xor(rs, 16);
        rs += __shfl_xor(rs, 32);
        l_run[qt] = l_run[qt] * alpha + rs;
        m_run[qt] = m_new;
#pragma unroll
        for (int dt = 0; dt < 4; ++dt) ot[qt][dt] *= alpha;
#pragma unroll
        for (int kk = 0; kk < 2; ++kk) {
          uint2 plo, phi;
          plo.x = cvt_pk_bf16(st[qt][2 * kk][0], st[qt][2 * kk][1]); plo.y = cvt_pk_bf16(st[qt][2 * kk][2], st[qt][2 * kk][3]);
          phi.x = cvt_pk_bf16(st[qt][2 * kk + 1][0], st[qt][2 * kk + 1][1]); phi.y = cvt_pk_bf16(st[qt][2 * kk + 1][2], st[qt][2 * kk + 1][3]);
          pb[qt][kk] = pack8(plo, phi);
        }
      }
#pragma unroll
      for (int kk = 0; kk < 2; ++kk)
#pragma unroll
        for (int dt = 0; dt < 4; ++dt) {
          const u16* vr = Vt + (dt * 16 + fr) * KST + fq * 4;
          const bf16x8 vf = pack8(*(const uint2*)(vr + (2 * kk) * 16), *(const uint2*)(vr + (2 * kk + 1) * 16));
          ot[0][dt] = __builtin_amdgcn_mfma_f32_16x16x32_bf16(vf, pb[0][kk], ot[0][dt], 0, 0, 0);
          ot[1][dt] = __builtin_amdgcn_mfma_f32_16x16x32_bf16(vf, pb[1][kk], ot[1][dt], 0, 0, 0);
        }
    }
    if (tt + 1 < ntile) ATT_LSTORE((tt + 1) & 1);
    __syncthreads();
  }
#undef ATT_GLOAD
#undef ATT_LSTORE
#pragma unroll
  for (int qt = 0; qt < 2; ++qt) {
    const float inv_l = __builtin_amdgcn_rcpf(l_run[qt]);
#pragma unroll
    for (int dt = 0; dt < 4; ++dt) {
      const size_t off = qtok[qt] * 1024 + head * 64 + dt * 16 + fq * 4;
      const size_t offq = qtok[qt] * 2048 + head * 64 + dt * 16 + fq * 4;
      uint2 g = *(const uint2*)(GB + off);
      uint2 o;
      o.x = cvt_pk_bf16(ot[qt][dt][0] * inv_l * bflo(g.x), ot[qt][dt][1] * inv_l * bfhi(g.x));
      o.y = cvt_pk_bf16(ot[qt][dt][2] * inv_l * bflo(g.y), ot[qt][dt][3] * inv_l * bfhi(g.y));
      *(uint2*)(Q + offq) = o;
    }
  }
}

__device__ __forceinline__ void phase_gn(const Params& p) {
  const u16* Y0 = (const u16*)(p.ws + OFF_ZA);
  const u16* Y1 = (const u16*)(p.ws + OFF_ZA + SZ_ACT);
  const u16* VC = (const u16*)(p.ws + OFF_VC);
  const float* BD = (const float*)(p.ws + OFF_BD);
  u16* GA = (u16*)(p.ws + OFF_AQ);
  const int gt = blockIdx.x * NTHR + threadIdx.x, gs = gridDim.x * NTHR;
  const int hi = gt & 127, h = hi >> 3, cbase = h * 64 + (hi & 7) * 8;
  float lw[8], lb[8];
#pragma unroll
  for (int e = 0; e < 8; ++e) { lw[e] = p.ln_w[cbase + e]; lb[e] = p.ln_b[cbase + e]; }
  for (int u = gt; u < NTOK * 128; u += gs) {
    const int tok = u >> 7;
    const size_t off = (size_t)tok * 1024 + cbase;
    bf16x8 a = *(const bf16x8*)(Y0 + off), bq = *(const bf16x8*)(Y1 + off);
    const size_t offg = (size_t)tok * 2048 + cbase;
    bf16x8 vc = *(const bf16x8*)(VC + off), g = *(const bf16x8*)(GA + offg);
    float y[8], s1 = 0, s2 = 0;
#pragma unroll
    for (int e = 0; e < 8; ++e) {
      y[e] = bf2f((u16)a[e]) + bf2f((u16)bq[e]);
      s1 += y[e];
      s2 += y[e] * y[e];
    }
    s1 = red8(s1);
    s2 = red8(s2);
    const float mu = s1 * (1.f / 64.f);
    const float var = fmaxf(s2 * (1.f / 64.f) - mu * mu, 0.f);
    const float rstd = rsqrtf(var + 64e-5f);
    const float bd = BD[tok * 16 + h];
    bf16x8 o;
#pragma unroll
    for (int e = 0; e < 8; ++e) {
      float v = (y[e] - mu) * rstd * lw[e] + lb[e] + bd * bf2f((u16)vc[e]);
      o[e] = (short)f2bf(v * bf2f((u16)g[e]));
    }
    *(bf16x8*)(GA + offg) = o;
  }
}

__device__ __forceinline__ void phase_final(const Params& p) {
  const int lane = threadIdx.x & 63, wv = threadIdx.x >> 6;
  for (int tok = blockIdx.x * 8 + wv; tok < NTOK; tok += gridDim.x * 8) {
    float* xr = p.out + (size_t)tok * 1024;
    float4 v[4];
    float ss = 0;
#pragma unroll
    for (int i = 0; i < 4; ++i) {
      v[i] = *(const float4*)(xr + i * 256 + lane * 4);
      ss += v[i].x * v[i].x + v[i].y * v[i].y + v[i].z * v[i].z + v[i].w * v[i].w;
    }
    ss = wave_sum(ss);
    float rstd = rsqrtf(ss * (1.f / 1024.f) + 1e-6f);
#pragma unroll
    for (int i = 0; i < 4; ++i) {
      float4 nw = *(const float4*)(p.fnw + i * 256 + lane * 4);
      float4 o = make_float4(v[i].x * rstd * nw.x, v[i].y * rstd * nw.y, v[i].z * rstd * nw.z, v[i].w * rstd * nw.w);
      *(float4*)(xr + i * 256 + lane * 4) = o;
    }
  }
}

#define XB_TMO      128
#define XB_XCNT(j)  (256  + 64 * (j))
#define XB_XSUB(j)  (1280 + 64 * (j))
#define XB_XGEN(j)  (2304 + 64 * (j))
#define XB_TOP      3328
#define XB_TOPGEN   3392
#define XCD_BAR_WORDS 3456
#define XB_SPIN_CAP (1u << 18)
__device__ __forceinline__ unsigned xb_xcc_id() { return (unsigned)__builtin_amdgcn_s_getreg((3 << 11) | 20) & 0xFu; }
#define XB_SPIN(cond, bar) do { unsigned _sp = 0; while (cond) { __builtin_amdgcn_s_sleep(1); \
    if ((++_sp & 255u) == 0u) { if (xb_ld(&(bar)[XB_TMO])) break; if (_sp > XB_SPIN_CAP) { atomicAdd(&(bar)[XB_TMO], 1u); break; } } } } while (0)
struct XcdBarrier { unsigned* bar; unsigned x; volatile LAS unsigned* st; };
__device__ __forceinline__ XcdBarrier xcd_barrier_post(unsigned* bar, volatile LAS unsigned* st) {
  XcdBarrier b; b.bar = bar; b.x = xb_xcc_id(); b.st = st;
  if (threadIdx.x == 0) (void)xb_add(&bar[XB_XCNT(b.x)], 1u);
  return b;
}
__device__ __forceinline__ void xcd_barrier_complete(unsigned* bar, unsigned x, unsigned& nloc, unsigned& nx) {
  const unsigned G = gridDim.x * gridDim.y * gridDim.z;
  unsigned sum, cnt, mine, sp = 0u;
  for (;;) {
    sum = 0u; cnt = 0u; mine = 0u;
#pragma unroll
    for (unsigned j = 0; j < 16; ++j) { const unsigned c = xb_ld(&bar[XB_XCNT(j)]); sum += c; cnt += (c > 0u) ? 1u : 0u; mine = (j == x) ? c : mine; }
    if (sum == G) break;
    __builtin_amdgcn_s_sleep(1);
    if ((++sp & 255u) == 0u) { if (xb_ld(&bar[XB_TMO])) break; if (sp > XB_SPIN_CAP) { atomicAdd(&bar[XB_TMO], 1u); break; } }
  }
  nloc = mine > 0u ? mine : 1u; nx = cnt > 0u ? cnt : 1u;
}
__device__ __forceinline__ void xcd_barrier(const XcdBarrier& b) {
  asm volatile("s_waitcnt vmcnt(0)" ::: "memory");
  __syncthreads();
  if (threadIdx.x == 0) {
    unsigned* bar = b.bar;
    __builtin_amdgcn_s_waitcnt(0);
    unsigned nloc = b.st[0], nx = b.st[1];
    if (nloc == 0u) { xcd_barrier_complete(bar, b.x, nloc, nx); b.st[0] = nloc; b.st[1] = nx; }
    const unsigned old = xb_add(&bar[XB_XSUB(b.x)], 1u);
    const unsigned gen = old / nloc;
    if (old + 1u == (gen + 1u) * nloc) {
      __builtin_amdgcn_fence(__ATOMIC_RELEASE, "agent");
      asm volatile("s_waitcnt vmcnt(0)" ::: "memory");
      const unsigned og = xb_add(&bar[XB_TOP], 1u);
      const unsigned tg = og / nx;
      if (og + 1u == (tg + 1u) * nx) xb_add(&bar[XB_TOPGEN], 1u);
      else XB_SPIN(xb_ld(&bar[XB_TOPGEN]) == tg, bar);
      __builtin_amdgcn_fence(__ATOMIC_ACQUIRE, "agent");
      xb_add(&bar[XB_XGEN(b.x)], 1u);
      asm volatile("s_waitcnt vmcnt(0)" ::: "memory");
    } else {
      XB_SPIN(xb_ld(&bar[XB_XGEN(b.x)]) == gen, bar);
      __builtin_amdgcn_fence(__ATOMIC_ACQUIRE, "agent");
      asm volatile("s_waitcnt vmcnt(0)" ::: "memory");
    }
  }
  __syncthreads();
}

__global__ void __launch_bounds__(NTHR) fwd_megakernel(Params p) {
  cg::grid_group grid = cg::this_grid();
  __shared__ int s_item[4];
  if (threadIdx.x == 0) { s_item[0] = 0; s_item[1] = 0; s_item[2] = 0; s_item[3] = 0; }
  __syncthreads();
  XcdBarrier xb = xcd_barrier_post((unsigned*)(p.ws + OFF_BAR), (volatile LAS unsigned*)&s_item[2]);
#ifndef PHM
#define PHM 0xFFFF
#endif
#ifndef DUP
#define DUP 0
#endif
  if (PHM & 1) phase0(p);
  if (DUP & 1) { __syncthreads(); phase0(p); }
  if (gridDim.x > 65535u) grid.sync();
  if (threadIdx.x == 0) {
    unsigned sp = 0;
    while (xb_ld((unsigned*)(p.ws + OFF_MCNT)) < 192u) { __builtin_amdgcn_s_sleep(1); if (++sp > (1u << 22)) break; }
    __builtin_amdgcn_fence(__ATOMIC_ACQUIRE, "agent");
    asm volatile("s_waitcnt vmcnt(0)" ::: "memory");
  }
  __syncthreads();
  if (PHM & 2) phase1(p);
  if (DUP & 2) phase1(p);
  xcd_barrier(xb);
  LAS unsigned char* lds = (LAS unsigned char*)smem_raw;
  if (PHM & 4) {
    Gemm g{(const u16*)(p.ws + OFF_H), (const u16*)(p.ws + OFF_WIN), 1024, 1024, 1024, NTOK, INWP};
    StaticOrder S; S.init(NTOK, INWP, (int)gridDim.x, (int)blockIdx.x);
    EpiIn E{p.ws, p.out};
    gemm_phase<EpiIn>(lds, g, S, E);
    if (DUP & 4) { __syncthreads(); gemm_phase<EpiIn>(lds, g, S, E); }
  }
  xcd_barrier(xb);
  if (PHM & 8) phase_conv(p);
  if (DUP & 8) phase_conv(p);
  xcd_barrier(xb);
  {
    int* qctr = (int*)(p.ws + OFF_QCTR);
    for (;;) {
      __syncthreads();
      if (threadIdx.x == 0) s_item[0] = atomicAdd(qctr, 1);
      __syncthreads();
      const int item = __builtin_amdgcn_readfirstlane(s_item[0]);
      if (item >= 1344) break;
      if (item < 64) { if (PHM & 16) scan_item(p, true, item); }
      else if (item < 576) { if (PHM & 16) scan_item(p, false, item - 64); }
      else if (item < 832) { if (PHM & 32) attn_item(p, true, item - 576); }
      else { if (PHM & 32) attn_item(p, false, item - 832); }
    }
  }
  xcd_barrier(xb);
  if (PHM & 128) {
    Gemm g{(const u16*)(p.ws + OFF_AQ), (const u16*)(p.ws + OFF_WO), 2048, 2048, 2048, NTOK, 1024};
    StaticOrder S; S.init(NTOK, 1024, (int)gridDim.x, (int)blockIdx.x, 64 * EpiMerge::MF);
    EpiMerge E{(const u16*)p.out, (u16*)(p.ws + OFF_ZA + 2 * SZ_ACT)};
    gemm_phase<EpiMerge>(lds, g, S, E);
    if (DUP & 32) { __syncthreads(); gemm_phase<EpiMerge>(lds, g, S, E); }
  }
  xcd_barrier(xb);
  if (PHM & 256) {
    Gemm g{(const u16*)(p.ws + OFF_ZA + 2 * SZ_ACT), (const u16*)(p.ws + OFF_WOUT), 1024, 1024, 1024, NTOK, 1024};
    StaticOrder S; S.init(NTOK, 1024, (int)gridDim.x, (int)blockIdx.x, 64 * EpiOut::MF);
    EpiOut E{p.x_prompt, p.x_sample, (const float*)(p.ws + OFF_MOD), p.fnw, p.out, (float*)(p.ws + OFF_RSUM), (unsigned*)(p.ws + OFF_PCNT)};
    gemm_phase<EpiOut>(lds, g, S, E);
    if (DUP & 64) { __syncthreads(); gemm_phase<EpiOut>(lds, g, S, E); }
  }
}

extern "C" void kernel_launch(void* const* d_in, const int* in_sizes, int n_in, void* d_out, int out_size, void* d_ws,
                              size_t ws_size, hipStream_t stream) {
  constexpr size_t kDynLds = 131072;
  static int grid_blocks = 0;
  if (!grid_blocks) {
    int dev = 0, cus = 0, per_cu = 0;
    hipGetDevice(&dev);
    hipDeviceGetAttribute(&cus, hipDeviceAttributeMultiprocessorCount, dev);
    hipFuncSetAttribute((const void*)fwd_megakernel, hipFuncAttributeMaxDynamicSharedMemorySize, (int)kDynLds);
    hipOccupancyMaxActiveBlocksPerMultiprocessor(&per_cu, (const void*)fwd_megakernel, NTHR, kDynLds);
    if (per_cu < 1) { fprintf(stderr, "occupancy query returned %d\n", per_cu); return; }
    if (cus < 256) { fprintf(stderr, "this kernel needs >= 256 CUs (fused final-norm epilogue: one 192-row unit per workgroup)\n"); return; }
    grid_blocks = cus;
  }
  if (ws_size < WS_NEED) { fprintf(stderr, "workspace too small: %zu < %zu\n", ws_size, WS_NEED); return; }
  Params p{};
  const float** pp = (const float**)&p;
  for (int i = 0; i < 26; ++i) pp[i] = (const float*)d_in[i];
  p.out = (float*)d_out;
  p.ws = (char*)d_ws;
  hipMemsetAsync((char*)d_ws + OFF_QCTR, 0, OFF_WIN - OFF_QCTR, stream);
  void* args[] = {&p};
  hipError_t e = hipLaunchCooperativeKernel((const void*)fwd_megakernel, dim3(grid_blocks), dim3(NTHR), args, kDynLds, stream);
  if (e != hipSuccess) fprintf(stderr, "cooperative launch failed: %s (grid %d)\n", hipGetErrorString(e), grid_blocks);
}
```
